# Optimizing an MI355X kernel written in HIP

```python
import jax, jax.numpy as jnp
from jax import lax
import numpy as np


D_MODEL = 1024
BATCH = 8
SEQ = 4096
DEPTH = 4

CTX_LEN = 256
GRID_W = 64
EPS = 1e-6
MIN_FORGET = 1e-20

D_MIX = D_MODEL
HG_HEADS = 4
HG_DIM = 64
HG_WIDTH = HG_HEADS * HG_DIM
HG_CHUNK = 64
MLA_HEADS = 6
MLA_NOPE = 64
MLA_ROPE = 32
MLA_V = 64
MLA_Q_RANK = 256
MLA_KV_RANK = 128
MLA_WIDTH = MLA_HEADS * MLA_V
NA_HEADS = 6
NA_DIM = 64
NA_WIDTH = NA_HEADS * NA_DIM
NA_WIN_R = 8
NA_WIN_C = 16
HG_IN = 5 * HG_WIDTH
MLA_IN = MLA_Q_RANK + MLA_KV_RANK + MLA_ROPE
NA_IN = 3 * NA_WIDTH
D_IN = HG_IN + MLA_IN + NA_IN
ROPE_BASE = 10000.0
Q_BLOCK = 128
N_EXPERTS = 16
EC_CAPACITY = 2
F_EXPERT = 1024

kernel_name = 'hybrid_hgrn2_mla_natten_ec_dit'


def _rmsnorm(x, g):
    x32 = x.astype(jnp.float32)
    y = x32 * lax.rsqrt(jnp.mean(x32 * x32, axis=-1, keepdims=True) + EPS)
    return (y * g.astype(jnp.float32)).astype(x.dtype)


def _split_heads(a, n_heads):
    B, L, W = a.shape
    return a.reshape(B, L, n_heads, W // n_heads).transpose(0, 2, 1, 3)


def _merge_heads(a):
    B, H, L, e = a.shape
    return a.transpose(0, 2, 1, 3).reshape(B, L, H * e)


def _rope_2d(x, n):
    t = jnp.arange(n)
    half = MLA_ROPE // 2
    inv = ROPE_BASE ** (-jnp.arange(0, half, 2, dtype=jnp.float32) / half)

    def rot(xa, pos):
        ang = pos.astype(jnp.float32)[:, None] * inv
        shape = (n,) + (1,) * (xa.ndim - 3) + (half // 2,)
        cos = jnp.cos(ang).reshape(shape).astype(xa.dtype)
        sin = jnp.sin(ang).reshape(shape).astype(xa.dtype)
        x1, x2 = xa[..., :half // 2], xa[..., half // 2:]
        return jnp.concatenate([x1 * cos - x2 * sin, x2 * cos + x1 * sin], axis=-1)

    return jnp.concatenate([rot(x[..., :half], t // GRID_W), rot(x[..., half:], t % GRID_W)], axis=-1)


def _softmax_attend(q, k, v, scale):
    s = jnp.einsum('bhqd,bhkd->bhqk', q, k).astype(jnp.float32) * scale
    p = jax.nn.softmax(s, axis=-1).astype(v.dtype)
    return jnp.einsum('bhqk,bhke->bhqe', p, v)


def _blocked_attend(q, k, v, scale):
    B, H, N, d = q.shape
    nb = N // Q_BLOCK
    qb = q.reshape(B, H, nb, Q_BLOCK, d).transpose(2, 0, 1, 3, 4)
    o = lax.map(lambda qq: _softmax_attend(qq, k, v, scale), qb)
    return o.transpose(1, 2, 0, 3, 4).reshape(B, H, N, v.shape[-1])


def _log_forget(z, lb):
    lb = lb.reshape(HG_HEADS, 1, HG_DIM).astype(jnp.float32)
    f = lb + (1.0 - lb) * jax.nn.sigmoid(z.astype(jnp.float32))
    return jnp.log(jnp.maximum(f, MIN_FORGET))


def _gla_chunk_scan(q, k, v, logf, s0):
    B, H, L, dk = q.shape
    dv = v.shape[-1]
    nc = L // HG_CHUNK

    def chunks(a):
        return a.reshape(B, H, nc, HG_CHUNK, a.shape[-1]).transpose(2, 0, 1, 3, 4)

    lower = jnp.tril(jnp.ones((HG_CHUNK, HG_CHUNK), dtype=bool))[..., None]

    def step(S, inp):
        qc, kc, vc, lf = inp
        b = jnp.cumsum(lf, axis=-2)
        diff = b[..., :, None, :] - b[..., None, :, :]
        decay = jnp.where(lower, jnp.exp(jnp.minimum(diff, 0.0)), 0.0).astype(qc.dtype)
        a = jnp.einsum('bhid,bhjd,bhijd->bhij', qc, kc, decay)
        o = (jnp.einsum('bhij,bhje->bhie', a, vc)
             + jnp.einsum('bhid,bhde->bhie', qc * jnp.exp(b).astype(qc.dtype), S))
        b_last = b[..., -1:, :]
        S = (S * jnp.exp(b_last)[..., 0, :, None].astype(S.dtype)
             + jnp.einsum('bhjd,bhje->bhde', kc * jnp.exp(b_last - b).astype(kc.dtype), vc))
        return S, o

    S, o = lax.scan(step, s0, (chunks(q), chunks(k), chunks(v), chunks(logf)))
    return o.transpose(1, 2, 0, 3, 4).reshape(B, H, L, dv), S


def _gla_final_state(k, v, logf):
    rest = lax.cumsum(logf, axis=2, reverse=True) - logf
    return jnp.einsum('bhjd,bhje->bhde', k * jnp.exp(jnp.minimum(rest, 0.0)).astype(k.dtype), v)


def _hgrn2_mixer(p_lat, p_ctx, lb, onorm_g, with_ctx_out):
    def prep(p):
        q, i, zf, zb, g = jnp.split(p, 5, axis=-1)
        q = _split_heads(q, HG_HEADS) * (HG_DIM ** -0.5)
        lf = (_log_forget(_split_heads(zf, HG_HEADS), lb[0]),
              _log_forget(_split_heads(zb, HG_HEADS), lb[1]))
        ks = (-jnp.expm1(lf[0]).astype(q.dtype), -jnp.expm1(lf[1]).astype(q.dtype))
        return q, _split_heads(i, HG_HEADS), lf, ks, g

    def flip(a):
        return jnp.flip(a, axis=2)

    def readout(o, g):
        return _merge_heads(_rmsnorm(o, onorm_g)) * jax.nn.silu(g)

    qc, ic, lfc, kc, gc = prep(p_ctx)
    ql, il, lfl, kl, gl = prep(p_lat)
    if with_ctx_out:
        zeros = jnp.zeros(qc.shape[:2] + (HG_DIM, HG_DIM), qc.dtype)
        oc_f, s_f = _gla_chunk_scan(qc, kc[0], ic, lfc[0], zeros)
        oc_b, s_b = _gla_chunk_scan(flip(qc), flip(kc[1]), flip(ic), flip(lfc[1]), zeros)
        o_ctx = readout(oc_f + flip(oc_b), gc)
    else:
        s_f = _gla_final_state(kc[0], ic, lfc[0])
        s_b = _gla_final_state(flip(kc[1]), flip(ic), flip(lfc[1]))
        o_ctx = None
    ol_f, _ = _gla_chunk_scan(ql, kl[0], il, lfl[0], s_f)
    ol_b, _ = _gla_chunk_scan(flip(ql), flip(kl[1]), flip(il), flip(lfl[1]), s_b)
    return readout(ol_f + flip(ol_b), gl), o_ctx


def _mla_mixer(p_lat, p_ctx, qnorm_g, w_uq, kvnorm_g, w_ukv, with_ctx_out):
    def project(p, rotate):
        B, L, _ = p.shape
        cq = p[..., :MLA_Q_RANK]
        ckv = p[..., MLA_Q_RANK:MLA_Q_RANK + MLA_KV_RANK]
        kr = p[..., MLA_Q_RANK + MLA_KV_RANK:]
        q = (_rmsnorm(cq, qnorm_g) @ w_uq).reshape(B, L, MLA_HEADS, MLA_NOPE + MLA_ROPE)
        kv = (_rmsnorm(ckv, kvnorm_g) @ w_ukv).reshape(B, L, MLA_HEADS, MLA_NOPE + MLA_V)
        q_nope, q_rope = q[..., :MLA_NOPE], q[..., MLA_NOPE:]
        k_nope, v = kv[..., :MLA_NOPE], kv[..., MLA_NOPE:]
        if rotate:
            q_rope = _rope_2d(q_rope, L)
            kr = _rope_2d(kr, L)
        k_rope = jnp.broadcast_to(kr[:, :, None, :], (B, L, MLA_HEADS, MLA_ROPE))
        q = jnp.concatenate([q_nope, q_rope], axis=-1).transpose(0, 2, 1, 3)
        k = jnp.concatenate([k_nope, k_rope], axis=-1).transpose(0, 2, 1, 3)
        return q, k, v.transpose(0, 2, 1, 3)

    scale = (MLA_NOPE + MLA_ROPE) ** -0.5
    ql, kl, vl = project(p_lat, True)
    qc, kc, vc = project(p_ctx, False)
    o_lat = _merge_heads(_blocked_attend(ql, jnp.concatenate([kl, kc], axis=2),
                                         jnp.concatenate([vl, vc], axis=2), scale))
    o_ctx = _merge_heads(_softmax_attend(qc, kc, vc, scale)) if with_ctx_out else None
    return o_lat, o_ctx


def _na_mixer(p_lat, p_ctx, rpb, with_ctx_out):
    ql, kl, vl = [_split_heads(a, NA_HEADS) for a in jnp.split(p_lat, 3, axis=-1)]
    qc, kc, vc = [_split_heads(a, NA_HEADS) for a in jnp.split(p_ctx, 3, axis=-1)]
    scale = NA_DIM ** -0.5
    B, H, N, d = ql.shape
    rows = N // GRID_W
    wr = min(NA_WIN_R, rows)
    kg = kl.reshape(B, H, rows, GRID_W, d)
    vg = vl.reshape(B, H, rows, GRID_W, d)
    cols = jnp.arange(GRID_W)
    col_idx = jnp.clip(cols - NA_WIN_C // 2, 0, GRID_W - NA_WIN_C)[:, None] + jnp.arange(NA_WIN_C)
    dcol = col_idx - cols[:, None] + (NA_WIN_C - 1)
    nwin = wr * NA_WIN_C

    def row_step(inp):
        r, q_r = inp
        rs = jnp.clip(r - wr // 2, 0, rows - wr)
        k_win = lax.dynamic_slice_in_dim(kg, rs, wr, axis=2)[:, :, :, col_idx]
        v_win = lax.dynamic_slice_in_dim(vg, rs, wr, axis=2)[:, :, :, col_idx]
        drow = rs + jnp.arange(wr) - r + (NA_WIN_R - 1)
        bias = rpb[:, drow[None, :, None], dcol[:, None, :]]
        s_win = (jnp.einsum('bhcd,bhrckd->bhcrk', q_r, k_win).astype(jnp.float32) * scale
                 + bias.astype(jnp.float32)).reshape(B, H, GRID_W, nwin)
        s_ctx = jnp.einsum('bhcd,bhjd->bhcj', q_r, kc).astype(jnp.float32) * scale
        p = jax.nn.softmax(jnp.concatenate([s_win, s_ctx], axis=-1), axis=-1).astype(vc.dtype)
        p_win = p[..., :nwin].reshape(B, H, GRID_W, wr, NA_WIN_C)
        return (jnp.einsum('bhcrk,bhrckd->bhcd', p_win, v_win)
                + jnp.einsum('bhcj,bhjd->bhcd', p[..., nwin:], vc))

    q_rows = ql.reshape(B, H, rows, GRID_W, d).transpose(2, 0, 1, 3, 4)
    o = lax.map(row_step, (jnp.arange(rows), q_rows))
    o_lat = o.transpose(1, 0, 3, 2, 4).reshape(B, N, H * d)
    o_ctx = _merge_heads(_softmax_attend(qc, kc, vc, scale)) if with_ctx_out else None
    return o_lat, o_ctx


def _ec_ffn(h, router_w, w1, w3, w2):
    B, L, D = h.shape
    cap = EC_CAPACITY * L // N_EXPERTS
    aff = jax.nn.softmax((h @ router_w).astype(jnp.float32), axis=-1)
    gate, idx = lax.top_k(aff.transpose(0, 2, 1), cap)
    xs = jax.vmap(lambda hb, ib: hb[ib])(h, idx)
    a = jnp.einsum('becd,edf->becf', xs, w1)
    u = jnp.einsum('becd,edf->becf', xs, w3)
    y = jnp.einsum('becf,efd->becd', jax.nn.silu(a) * u, w2) * gate[..., None].astype(h.dtype)
    return jax.vmap(lambda yb, ib: jnp.zeros((L, D), h.dtype).at[ib.reshape(-1)].add(yb.reshape(-1, D)))(y, idx)


def setup_inputs(seed: int = 0) -> dict:
    key = jax.random.key(seed)
    ks = jax.random.split(key, 22)

    def nrm(k, shape, scale):
        return jax.random.normal(k, shape, jnp.float32) * scale

    return {
        'x': nrm(ks[0], (BATCH, SEQ, D_MODEL), 1.0),
        'c': nrm(ks[1], (BATCH, D_MODEL), 1.0),
        'ctx': nrm(ks[2], (BATCH, CTX_LEN, D_MODEL), 1.0),
        'c_ctx': nrm(ks[3], (D_MODEL,), 1.0),
        'ada_w': nrm(ks[4], (DEPTH, D_MODEL, 6 * D_MODEL), 0.5 * D_MODEL ** -0.5),
        'ada_b': nrm(ks[5], (DEPTH, 6 * D_MODEL), 0.02),
        'norm_mix_g': 1.0 + nrm(ks[6], (DEPTH, D_MODEL), 0.02),
        'norm_ffn_g': 1.0 + nrm(ks[7], (DEPTH, D_MODEL), 0.02),
        'w_in': nrm(ks[8], (DEPTH, D_MODEL, D_IN), D_MODEL ** -0.5),
        'hgrn_lb_logits': nrm(ks[9], (2, DEPTH, HG_WIDTH), 0.1),
        'hgrn_onorm_g': 1.0 + nrm(ks[10], (DEPTH, HG_DIM), 0.02),
        'mla_qnorm_g': 1.0 + nrm(ks[11], (DEPTH, MLA_Q_RANK), 0.02),
        'mla_w_uq': nrm(ks[12], (DEPTH, MLA_Q_RANK, MLA_HEADS * (MLA_NOPE + MLA_ROPE)), MLA_Q_RANK ** -0.5),
        'mla_kvnorm_g': 1.0 + nrm(ks[13], (DEPTH, MLA_KV_RANK), 0.02),
        'mla_w_ukv': nrm(ks[14], (DEPTH, MLA_KV_RANK, MLA_HEADS * (MLA_NOPE + MLA_V)), MLA_KV_RANK ** -0.5),
        'na_rpb': nrm(ks[15], (DEPTH, NA_HEADS, 2 * NA_WIN_R - 1, 2 * NA_WIN_C - 1), 0.1),
        'w_out': nrm(ks[16], (DEPTH, D_MIX, D_MODEL), D_MIX ** -0.5),
        'router_w': nrm(ks[17], (DEPTH, D_MODEL, N_EXPERTS), D_MODEL ** -0.5),
        'exp_w1': nrm(ks[18], (DEPTH, N_EXPERTS, D_MODEL, F_EXPERT), D_MODEL ** -0.5),
        'exp_w3': nrm(ks[19], (DEPTH, N_EXPERTS, D_MODEL, F_EXPERT), D_MODEL ** -0.5),
        'exp_w2': nrm(ks[20], (DEPTH, N_EXPERTS, F_EXPERT, D_MODEL), F_EXPERT ** -0.5),
        'final_norm_g': 1.0 + nrm(ks[21], (D_MODEL,), 0.02),
    }


def reference(x, c, ctx, c_ctx, ada_w, ada_b, norm_mix_g, norm_ffn_g, w_in, hgrn_lb_logits,
              hgrn_onorm_g, mla_qnorm_g, mla_w_uq, mla_kvnorm_g, mla_w_ukv, na_rpb, w_out,
              router_w, exp_w1, exp_w3, exp_w2, final_norm_g):
    lb_w = jax.nn.softmax(hgrn_lb_logits.astype(jnp.float32), axis=1)
    lb_all = jnp.cumsum(lb_w, axis=1) - lb_w[:, :1]
    s_lat = jax.nn.silu(c)
    s_ctx = jax.nn.silu(c_ctx)
    for layer in range(DEPTH):
        with_ctx_out = layer < DEPTH - 1
        mod_l = (s_lat @ ada_w[layer] + ada_b[layer])[:, None, :]
        mod_c = s_ctx @ ada_w[layer] + ada_b[layer]
        sh_a, sc_a, g_a, sh_f, sc_f, g_f = jnp.split(mod_l, 6, axis=-1)
        csh_a, csc_a, cg_a, csh_f, csc_f, cg_f = jnp.split(mod_c, 6, axis=-1)

        h_l = _rmsnorm(x, norm_mix_g[layer]) * (1.0 + sc_a) + sh_a
        h_c = _rmsnorm(ctx, norm_mix_g[layer]) * (1.0 + csc_a) + csh_a
        p_l = h_l @ w_in[layer]
        p_c = h_c @ w_in[layer]
        a0, a1 = HG_IN, HG_IN + MLA_IN
        hg_l, hg_c = _hgrn2_mixer(p_l[..., :a0], p_c[..., :a0], lb_all[:, layer],
                                  hgrn_onorm_g[layer], with_ctx_out)
        ml_l, ml_c = _mla_mixer(p_l[..., a0:a1], p_c[..., a0:a1], mla_qnorm_g[layer], mla_w_uq[layer],
                                mla_kvnorm_g[layer], mla_w_ukv[layer], with_ctx_out)
        na_l, na_c = _na_mixer(p_l[..., a1:], p_c[..., a1:], na_rpb[layer], with_ctx_out)
        x = x + g_a * (jnp.concatenate([hg_l, ml_l, na_l], axis=-1) @ w_out[layer])

        h = _rmsnorm(x, norm_ffn_g[layer]) * (1.0 + sc_f) + sh_f
        x = x + g_f * _ec_ffn(h, router_w[layer], exp_w1[layer], exp_w3[layer], exp_w2[layer])

        if with_ctx_out:
            ctx = ctx + cg_a * (jnp.concatenate([hg_c, ml_c, na_c], axis=-1) @ w_out[layer])
            hc = _rmsnorm(ctx, norm_ffn_g[layer]) * (1.0 + csc_f) + csh_f
            ctx = ctx + cg_f * _ec_ffn(hc, router_w[layer], exp_w1[layer], exp_w3[layer], exp_w2[layer])
    return _rmsnorm(x, final_norm_g)
```

```cpp
#include <hip/hip_runtime.h>
#include <cstdio>
#include <cstdint>
namespace pg8 {
#define PG8_LAS __attribute__((address_space(3)))
typedef unsigned short bf16_t;
typedef short bf16x8 __attribute__((ext_vector_type(8)));
typedef float f32x4 __attribute__((ext_vector_type(4)));
typedef unsigned u32x4 __attribute__((ext_vector_type(4)));
constexpr int BM = 256, BK = 64, HALF = 128, HTB = HALF * BK * 2  , STAGE_BYTES = 8 * HTB, NXCD = 8, WGM = 8;

__host__ __device__ __forceinline__ int lds_byte(int r, int c) { const int st = (r >> 4) * 2 + (c >> 5), rr = r & 15, cc = c & 31, ob = rr * 64 + cc * 2; return st * 1024 + (ob ^ (((ob >> 9) & 1) << 5)); }
__host__ __device__ __forceinline__ void stage_rc(int b, int& R, int& C) { const int st = b / 1024, sb = b % 1024, swz = sb ^ (((sb >> 9) & 1) << 5); R = (st >> 1) * 16 + swz / 64; C = (st & 1) * 32 + (swz % 64) / 2; }
__host__ __device__ __forceinline__ int perm32(int rho) { const int n = rho >> 4, i = rho & 15; return 8 * (i >> 2) + 4 * n + (i & 3); }

struct Unit { int pm, pn, kt0 = 0, ntu = 0; };
struct Gemm { const bf16_t* A; const bf16_t* Bt; int M, N, K; };

struct StaticOrder {
    int nM, nN, nwg, G, c, bdiag = 0;
    __host__ __device__ void init(int M, int N, int G_, int c_) { nM = M / BM; nN = N / BM; nwg = nM * nN; G = G_; c = c_; }
    __host__ __device__ bool next(int i, Unit& u) const {
        const long L = (long)i * G + c; if (L >= nwg) return false;
        int wgid = (int)L; { const int q = nwg / NXCD, r = nwg % NXCD, xcd = wgid % NXCD, off = wgid / NXCD; wgid = (xcd < r ? xcd * (q + 1) : r * (q + 1) + (xcd - r) * q) + off; }
        const int nig = WGM * nN, gid = wgid / nig, fm = gid * WGM, gsz = (nM - fm) < WGM ? (nM - fm) : WGM;
        u.pm = fm + ((wgid % nig) % gsz); u.pn = (wgid % nig) / gsz; u.kt0 = 0; u.ntu = 0; if (bdiag) { if (u.pn < 3) u.ntu = 4; else { u.kt0 = 4; u.ntu = 2; } } return true;
    }
    __device__ __forceinline__ void a_ready(const Unit&) const {}
    __device__ __forceinline__ void done(const Unit&) const {}
};
__device__ __forceinline__ unsigned cvt_pk_bf16(float lo, float hi) { unsigned r; asm volatile("v_cvt_pk_bf16_f32 %0, %1, %2" : "=v"(r) : "v"(lo), "v"(hi)); return r; }
typedef float f32x2 __attribute__((ext_vector_type(2)));
template <class Epi, class Sched, bool ALIGN_EPI = false, bool SP2 = false, int KC = 0, bool GATHER = false>
__device__ __forceinline__ void gemm_phase(PG8_LAS unsigned char* lds, const Gemm g, const Sched& S, const Epi& E, int wave_id, const int* gidx = nullptr) {
    int tid_l; asm volatile("v_mbcnt_lo_u32_b32 %0, -1, 0\n\tv_mbcnt_hi_u32_b32 %0, -1, %0" : "=v"(tid_l)); tid_l += wave_id * 64;
    const int tid = tid_l, wid = __builtin_amdgcn_readfirstlane(tid >> 6), lane = tid & 63, wr = wid >> 2, wc = wid & 3, fr = lane & 15, fq = lane >> 4;
    const int K = KC ? KC : g.K, nt = K / BK;
    unsigned voffA[2], voffB[2];
#pragma unroll
    for (int i = 0; i < 2; ++i) { int R, C; stage_rc(tid * 16 + i * 8192, R, C); const int Rb = Epi::PERM ? ((R & ~31) + perm32(R & 31)) : R;
        voffA[i] = (unsigned)(R * K + C) * 2u; voffB[i] = (unsigned)(Rb * K + C) * 2u; }
    unsigned rcA[2], gC[2][2], gN[2][2];
#pragma unroll
    for (int i = 0; i < 2; ++i) { int R, C; stage_rc(tid * 16 + i * 8192, R, C); rcA[i] = (unsigned)R | ((unsigned)(C * 2) << 16); gC[0][i] = gC[1][i] = gN[0][i] = gN[1][i] = 0u; }
#define PG8_GLOAD(dst, u) do { _Pragma("unroll") for (int h_ = 0; h_ < 2; ++h_) _Pragma("unroll") for (int i_ = 0; i_ < 2; ++i_) \
        dst[h_][i_] = (unsigned)gidx[(u).pm * BM + h_ * HALF + (int)(rcA[i_] & 0xffffu)] * (unsigned)(K * 2) + (rcA[i_] >> 16); } while (0)
#define PG8_STAGE_A(bufoff, gbase, h, nx) do { if constexpr (GATHER) { unsigned vs_[2] = {(nx) ? gN[h][0] : gC[h][0], (nx) ? gN[h][1] : gC[h][1]}; PG8_STAGE(bufoff, gbase, vs_); } \
        else { PG8_STAGE(bufoff, (gbase) + ((h) ? hstep : 0), voffA); } } while (0)
    const size_t kstep = (size_t)(BK * 2);
    const size_t hstep = (size_t)HALF * K * 2;
    const size_t tstep = 2 * hstep;
    const unsigned ldsw = (unsigned)wid * 1024u;
    const int aoff = lds_byte(wr * 64 + fr, fq * 8), boff = lds_byte(wc * 32 + fr, fq * 8);
#define PG8_SA(b, h) (((b) * 2 + (h)) * HTB)
#define PG8_SB(b, h) ((4 + (b) * 2 + (h)) * HTB)
#define PG8_STAGE(bufoff, gbase, voff) do { _Pragma("unroll") for (int _i = 0; _i < 2; ++_i) \
        __builtin_amdgcn_global_load_lds((const unsigned*)((const char*)(gbase) + (voff)[_i]), (PG8_LAS unsigned*)(lds + (bufoff) + ldsw + _i * 8192), 16, 0, 0); } while (0)
#define PG8_LDA(dst, b, h) do { _Pragma("unroll") for (int m = 0; m < 4; ++m) _Pragma("unroll") for (int k = 0; k < 2; ++k) dst[m][k] = *(const PG8_LAS bf16x8*)(lds + PG8_SA(b, h) + aoff + m * 2048 + k * 1024); } while (0)
#define PG8_LDB(dst, b, h) do { _Pragma("unroll") for (int n = 0; n < 2; ++n) _Pragma("unroll") for (int k = 0; k < 2; ++k) dst[n][k] = *(const PG8_LAS bf16x8*)(lds + PG8_SB(b, h) + boff + n * 2048 + k * 1024); } while (0)
#define PG8_MMA(ai, bj, At, Bt) do { __builtin_amdgcn_s_setprio(1); _Pragma("unroll") for (int m = 0; m < 4; ++m) _Pragma("unroll") for (int n = 0; n < 2; ++n) _Pragma("unroll") for (int k = 0; k < 2; ++k) \
        acc[ai][bj][m][n] = __builtin_amdgcn_mfma_f32_16x16x32_bf16(Bt[n][k], At[m][k], acc[ai][bj][m][n], 0, 0, 0); __builtin_amdgcn_s_setprio(0); } while (0)
#define PG8_WAIT_V(n) asm volatile("s_waitcnt vmcnt(" #n ")" ::: "memory")
#define PG8_WAIT_L(n) asm volatile("s_waitcnt lgkmcnt(" #n ")" ::: "memory")
#define PG8_BAR __builtin_amdgcn_s_barrier()
#define PG8_SCHED __builtin_amdgcn_sched_barrier(0)
    Unit cur, nxt; int ui = 0;
    if (!S.next(0, cur)) return;
    f32x4 acc[2][2][4][2];
#pragma unroll
    for (int a = 0; a < 2; ++a)
#pragma unroll
        for (int b = 0; b < 2; ++b)
#pragma unroll
            for (int m = 0; m < 4; ++m)
#pragma unroll
                for (int n = 0; n < 2; ++n) acc[a][b][m][n] = (f32x4){0.f, 0.f, 0.f, 0.f};
    bf16x8 At[4][2], B0[2][2], B1[2][2];
    const char* cA = (const char*)g.A + (GATHER ? (size_t)0 : (size_t)cur.pm * tstep) + (size_t)cur.kt0 * kstep; const char* cB = (const char*)g.Bt + (size_t)cur.pn * tstep + (size_t)cur.kt0 * kstep;
    S.a_ready(cur);
    if constexpr (GATHER) PG8_GLOAD(gC, cur);
    if constexpr (SP2) {
        PG8_STAGE(PG8_SB(0, 0), cB, voffB); PG8_STAGE(PG8_SB(0, 1), cB + hstep, voffB); PG8_STAGE_A(PG8_SA(0, 0), cA, 0, false); PG8_STAGE_A(PG8_SA(0, 1), cA, 1, false);
        if (wr == 1) PG8_BAR;
        PG8_WAIT_V(2); PG8_BAR;
        PG8_STAGE(PG8_SB(1, 0), cB + kstep, voffB); PG8_STAGE_A(PG8_SA(1, 0), cA + kstep, 0, false); PG8_STAGE(PG8_SB(1, 1), cB + hstep + kstep, voffB);
        PG8_WAIT_V(6); PG8_BAR;
    } else {
        PG8_STAGE(PG8_SB(0, 0), cB, voffB); PG8_STAGE_A(PG8_SA(0, 0), cA, 0, false); PG8_STAGE(PG8_SB(0, 1), cB + hstep, voffB); PG8_STAGE_A(PG8_SA(0, 1), cA, 1, false);
        if (wr == 1) PG8_BAR;
        PG8_WAIT_V(4); PG8_BAR;
        PG8_STAGE(PG8_SB(1, 0), cB + kstep, voffB); PG8_STAGE_A(PG8_SA(1, 0), cA + kstep, 0, false); PG8_STAGE(PG8_SB(1, 1), cB + hstep + kstep, voffB);
        PG8_WAIT_V(6); PG8_BAR;
    }
    for (;;) {
        const bool has_next = S.next(ui + 1, nxt);
        const char* nA = (has_next && !GATHER) ? (const char*)g.A + (size_t)nxt.pm * tstep + (size_t)nxt.kt0 * kstep : cA; const char* nB = has_next ? (const char*)g.Bt + (size_t)nxt.pn * tstep + (size_t)nxt.kt0 * kstep : cB;
        const int ntc = cur.ntu ? cur.ntu : nt;
        if constexpr (GATHER) { if (has_next) PG8_GLOAD(gN, nxt); else { gN[0][0] = gC[0][0]; gN[0][1] = gC[0][1]; gN[1][0] = gC[1][0]; gN[1][1] = gC[1][1]; } }
#pragma unroll 1
        for (int t = 0; t < ntc; t += 2) {
            const bool last = (t == ntc - 2);
            const char* a1 = cA + (size_t)(t + 1) * kstep;
            const char* a2 = last ? nA : cA + (size_t)(t + 2) * kstep; const char* b2 = last ? nB : cB + (size_t)(t + 2) * kstep;
            const char* a3 = a2 + kstep; const char* b3 = b2 + kstep;
            if (last && has_next) S.a_ready(nxt);
            if constexpr (SP2) {
            PG8_LDB(B0, 0, 0); PG8_LDB(B1, 0, 1); PG8_SCHED; PG8_LDA(At, 0, 0); PG8_STAGE_A(PG8_SA(1, 1), a1, 1, false);
            PG8_WAIT_V(8); PG8_WAIT_L(0); PG8_BAR; PG8_MMA(0, 0, At, B0); PG8_MMA(0, 1, At, B1); PG8_BAR; PG8_SCHED;
            PG8_LDA(At, 0, 1); PG8_STAGE(PG8_SB(0, 0), b2, voffB); PG8_STAGE(PG8_SB(0, 1), b2 + hstep, voffB); PG8_STAGE_A(PG8_SA(0, 0), a2, 0, last);
            PG8_WAIT_V(8); PG8_WAIT_L(0); PG8_BAR; PG8_MMA(1, 0, At, B0); PG8_MMA(1, 1, At, B1); PG8_BAR; PG8_SCHED;
            PG8_LDB(B0, 1, 0); PG8_LDB(B1, 1, 1); PG8_SCHED; PG8_LDA(At, 1, 0); PG8_STAGE_A(PG8_SA(0, 1), a2, 1, last);
            PG8_WAIT_V(8); PG8_WAIT_L(0); PG8_BAR; PG8_MMA(0, 0, At, B0); PG8_MMA(0, 1, At, B1); PG8_BAR; PG8_SCHED;
            PG8_LDA(At, 1, 1); PG8_STAGE(PG8_SB(1, 0), b3, voffB); PG8_STAGE(PG8_SB(1, 1), b3 + hstep, voffB); PG8_STAGE_A(PG8_SA(1, 0), a3, 0, last);
            PG8_WAIT_V(8); PG8_WAIT_L(0); PG8_BAR; PG8_MMA(1, 0, At, B0); PG8_MMA(1, 1, At, B1); PG8_BAR; PG8_SCHED;
            } else {
            PG8_LDB(B0, 0, 0); PG8_SCHED; PG8_LDA(At, 0, 0); PG8_STAGE_A(PG8_SA(1, 1), a1, 1, false);
            PG8_WAIT_L(8); PG8_BAR; PG8_WAIT_L(0); PG8_MMA(0, 0, At, B0); PG8_BAR; PG8_SCHED;
            PG8_LDB(B1, 0, 1); PG8_STAGE(PG8_SB(0, 0), b2, voffB);
            PG8_BAR; PG8_WAIT_L(0); PG8_MMA(0, 1, At, B1); PG8_BAR;
            PG8_LDA(At, 0, 1); PG8_STAGE_A(PG8_SA(0, 0), a2, 0, last);
            PG8_BAR; PG8_WAIT_L(0); PG8_MMA(1, 0, At, B0); PG8_BAR; PG8_SCHED;
            PG8_STAGE(PG8_SB(0, 1), b2 + hstep, voffB);
            PG8_WAIT_V(6); PG8_BAR; PG8_MMA(1, 1, At, B1); PG8_BAR;
            PG8_LDB(B0, 1, 0); PG8_SCHED; PG8_LDA(At, 1, 0); PG8_STAGE_A(PG8_SA(0, 1), a2, 1, last);
            PG8_WAIT_L(8); PG8_BAR; PG8_WAIT_L(0); PG8_MMA(0, 0, At, B0); PG8_BAR; PG8_SCHED;
            PG8_LDB(B1, 1, 1); PG8_STAGE(PG8_SB(1, 0), b3, voffB);
            PG8_BAR; PG8_WAIT_L(0); PG8_MMA(0, 1, At, B1); PG8_BAR;
            PG8_LDA(At, 1, 1); PG8_STAGE_A(PG8_SA(1, 0), a3, 0, last);
            PG8_BAR; PG8_WAIT_L(0); PG8_MMA(1, 0, At, B0); PG8_BAR; PG8_SCHED;
            PG8_STAGE(PG8_SB(1, 1), b3 + hstep, voffB);
            PG8_WAIT_V(6); PG8_BAR; PG8_MMA(1, 1, At, B1); PG8_BAR;
            }
        }
        if constexpr (ALIGN_EPI) { if (wr == 0) PG8_BAR; }
        if constexpr (!Epi::AFTER_DRAIN) { int fr_e = fr, fq_e = fq; asm volatile("" : "+v"(fr_e), "+v"(fq_e)); E(acc, cur, wr, wc, fr_e, fq_e); S.done(cur); }
        if (!has_next) break;
#pragma unroll
        for (int a = 0; a < 2; ++a)
#pragma unroll
            for (int b = 0; b < 2; ++b)
#pragma unroll
                for (int m = 0; m < 4; ++m)
#pragma unroll
                    for (int n = 0; n < 2; ++n) acc[a][b][m][n] = (f32x4){0.f, 0.f, 0.f, 0.f};
        cur = nxt; cA = nA; cB = nB; ++ui;
        if constexpr (GATHER) { gC[0][0] = gN[0][0]; gC[0][1] = gN[0][1]; gC[1][0] = gN[1][0]; gC[1][1] = gN[1][1]; }
        if constexpr (ALIGN_EPI) { if (wr == 1) PG8_BAR; }
    }
    PG8_WAIT_V(0);
    if constexpr (!ALIGN_EPI) { if (wr == 0) PG8_BAR; }
    PG8_BAR;
    if constexpr (Epi::AFTER_DRAIN) { E.fused(acc, cur, wr, wc, fr, fq, lds, wid, lane); S.done(cur); }
#undef PG8_SA
#undef PG8_SB
#undef PG8_STAGE
#undef PG8_STAGE_A
#undef PG8_GLOAD
#undef PG8_LDA
#undef PG8_LDB
#undef PG8_MMA
#undef PG8_WAIT_V
#undef PG8_WAIT_L
#undef PG8_BAR
#undef PG8_SCHED
}
}

#define GAS __attribute__((address_space(1)))
#define LAS __attribute__((address_space(3)))
typedef unsigned short bf16;
typedef unsigned v4u __attribute__((ext_vector_type(4)));
typedef unsigned v2u __attribute__((ext_vector_type(2)));
typedef float f32x4 __attribute__((ext_vector_type(4)));
typedef float f32x2 __attribute__((ext_vector_type(2)));

constexpr int NB = 8, T = 4096, NC = 256, D = 1024, DEPTH = 4;
constexpr int MLAT = NB * T, MCTX = NB * NC, MALL = MLAT + MCTX;
constexpr int NP = 3072;
constexpr int HG_Q = 0, HG_I = 256, HG_ZF = 512, HG_ZB = 768, HG_G = 1024, ML_CQ = 1280, ML_CKV = 1536, ML_KR = 1664, NA_Q = 1792, NA_K = 2176, NA_V = 2560;
constexpr int NKT = 68;
constexpr int NQK = T + NC;
constexpr int NE = 16, CAPL = 512, CAPC = 32;
constexpr int XS_LAT = NB * NE * CAPL, XS_ROWS = XS_LAT + NB * NE * CAPC;
constexpr int NHS = 67;
constexpr float EPS = 1e-6f;
constexpr float LOG2E = 1.4426950408889634f;
constexpr float MLA_QS = 0.10206207261596577f * LOG2E;
constexpr float NA_QS = 0.125f * LOG2E;

constexpr size_t MiB = 1u << 20;
constexpr size_t WS_CTL = 0, CTL_BYTES = 1 * MiB;
constexpr size_t WS_MOD = 1 * MiB;
constexpr size_t WS_LB = 2 * MiB;
constexpr size_t WS_ROPE = 2 * MiB + 65536;
constexpr size_t WS_WIN = 3 * MiB;
constexpr size_t WS_WMLA = 9 * MiB;
constexpr size_t WS_WOUT = 11 * MiB;
constexpr size_t WS_W13 = 13 * MiB;
constexpr size_t WS_W2 = 77 * MiB;
constexpr size_t WS_X = 109 * MiB;
constexpr size_t WS_H = 245 * MiB;
constexpr size_t WS_MIX = 313 * MiB;
constexpr size_t WS_AFF = 381 * MiB;
constexpr size_t WS_IDX = 384 * MiB;
constexpr size_t WS_GV = 384 * MiB + 512 * 1024;
constexpr size_t WS_SEL = 823 * MiB;
constexpr size_t WS_P = 385 * MiB;
constexpr size_t WS_AM = 589 * MiB;
constexpr size_t WS_QM = 615 * MiB;
constexpr size_t WS_KM = 654 * MiB;
constexpr size_t WS_VM = 693 * MiB;
constexpr size_t WS_HU = 719 * MiB;
constexpr size_t WS_HD = 787 * MiB;
constexpr size_t WS_OF = 789 * MiB;
constexpr size_t WS_XS = 385 * MiB;
constexpr size_t WS_ACT = 521 * MiB;
constexpr size_t WS_Y = WS_XS;
constexpr size_t WS_END = 826 * MiB;

constexpr int RING_BYTES = 155648, MISC_OFF = RING_BYTES, LDS_BYTES = RING_BYTES + 1024;
constexpr int NPH_LAYER = 10, NPHASES = 1 + DEPTH * NPH_LAYER + 1;

struct KP { const float* in[22]; float* out; unsigned char* ws; int ph_lo, ph_hi, li, pad; };
typedef const __attribute__((address_space(4))) KP* KA;

__device__ __forceinline__ float bf2f(unsigned u) { return __uint_as_float(u << 16); }
__device__ __forceinline__ unsigned f2bf(float f) { unsigned u = __float_as_uint(f); return (u + 0x7fffu + ((u >> 16) & 1u)) >> 16; }
__device__ __forceinline__ unsigned pk2(float lo, float hi) { return f2bf(lo) | (f2bf(hi) << 16); }
typedef float f32x2_t __attribute__((ext_vector_type(2)));
typedef __bf16 bf16x2_t __attribute__((ext_vector_type(2)));
__device__ __forceinline__ unsigned cvtpk(float lo, float hi) { f32x2_t v = {lo, hi}; bf16x2_t b = __builtin_convertvector(v, bf16x2_t); return __builtin_bit_cast(unsigned, b); }
__device__ __forceinline__ int lane_id_asm() { int l; asm volatile("v_mbcnt_lo_u32_b32 %0, -1, 0\n\tv_mbcnt_hi_u32_b32 %0, -1, %0" : "=v"(l)); return l; }
#define DPP_F(v, ctrl) __int_as_float(__builtin_amdgcn_update_dpp(0, __float_as_int(v), (ctrl), 0xf, 0xf, true))
#define DPP_I(v, ctrl) __builtin_amdgcn_update_dpp(0, (int)(v), (ctrl), 0xf, 0xf, true)
__device__ __forceinline__ float rdlane(float v, int l) { return __int_as_float(__builtin_amdgcn_readlane(__float_as_int(v), l)); }
__device__ __forceinline__ float wave_sum(float v) {
    v += DPP_F(v, 0xB1); v += DPP_F(v, 0x4E); v += DPP_F(v, 0x141); v += DPP_F(v, 0x140);
    return (rdlane(v, 0) + rdlane(v, 16)) + (rdlane(v, 32) + rdlane(v, 48));
}
__device__ __forceinline__ float wave_max(float v) {
    v = fmaxf(v, DPP_F(v, 0xB1)); v = fmaxf(v, DPP_F(v, 0x4E)); v = fmaxf(v, DPP_F(v, 0x141)); v = fmaxf(v, DPP_F(v, 0x140));
    return fmaxf(fmaxf(rdlane(v, 0), rdlane(v, 16)), fmaxf(rdlane(v, 32), rdlane(v, 48)));
}
__device__ __forceinline__ unsigned wave_sum_u(unsigned v) {
    v += (unsigned)DPP_I(v, 0xB1); v += (unsigned)DPP_I(v, 0x4E); v += (unsigned)DPP_I(v, 0x141); v += (unsigned)DPP_I(v, 0x140);
    return (unsigned)(__builtin_amdgcn_readlane((int)v, 0) + __builtin_amdgcn_readlane((int)v, 16) + __builtin_amdgcn_readlane((int)v, 32) + __builtin_amdgcn_readlane((int)v, 48));
}
__device__ __forceinline__ unsigned wave_incl_scan_u(unsigned v, int lane) {
    v += (unsigned)DPP_I(v, 0x111); v += (unsigned)DPP_I(v, 0x112); v += (unsigned)DPP_I(v, 0x114); v += (unsigned)DPP_I(v, 0x118);
    const unsigned t0 = (unsigned)__builtin_amdgcn_readlane((int)v, 15), t1 = (unsigned)__builtin_amdgcn_readlane((int)v, 31), t2 = (unsigned)__builtin_amdgcn_readlane((int)v, 47);
    const int r = lane >> 4; return v + (r > 0 ? t0 : 0u) + (r > 1 ? t1 : 0u) + (r > 2 ? t2 : 0u);
}
__device__ __forceinline__ float sigmoidf_(float v) { return 1.f / (1.f + expf(-v)); }
__device__ __forceinline__ void unpack8(const v4u k, float* o) {
    o[0] = bf2f(k.x & 0xffffu); o[1] = bf2f(k.x >> 16); o[2] = bf2f(k.y & 0xffffu); o[3] = bf2f(k.y >> 16); o[4] = bf2f(k.z & 0xffffu); o[5] = bf2f(k.z >> 16); o[6] = bf2f(k.w & 0xffffu); o[7] = bf2f(k.w >> 16);
}
#define LDS_WAIT() asm volatile("s_waitcnt lgkmcnt(0)" ::: "memory")
#define XB_TMO      128
#define XB_XCNT(j)  (256  + 64 * (j))
#define XB_XSUB(j)  (1280 + 64 * (j))
#define XB_XGEN(j)  (2304 + 64 * (j))
#define XB_TOP      3328
#define XB_TOPGEN   3392
#define XCD_BAR_WORDS 3456
#define XB_SPIN_CAP (1u << 18)

__device__ __forceinline__ unsigned xb_ld(unsigned* p)              { return __hip_atomic_load(p, __ATOMIC_RELAXED, __HIP_MEMORY_SCOPE_AGENT); }
__device__ __forceinline__ unsigned xb_add(unsigned* p, unsigned v) { return __hip_atomic_fetch_add(p, v, __ATOMIC_RELAXED, __HIP_MEMORY_SCOPE_AGENT); }
__device__ __forceinline__ unsigned xb_xcc_id() { return (unsigned)__builtin_amdgcn_s_getreg((3 << 11) | 20) & 0xFu; }
#define XB_SPIN(cond, bar) do { unsigned _sp = 0; while (cond) { __builtin_amdgcn_s_sleep(1); \
    if ((++_sp & 255u) == 0u) { if (xb_ld(&(bar)[XB_TMO])) break; if (_sp > XB_SPIN_CAP) { atomicAdd(&(bar)[XB_TMO], 1u); break; } } } } while (0)

struct XcdBarrier {
    unsigned* bar; unsigned x;
    volatile LAS unsigned* st;
};

__device__ __forceinline__ XcdBarrier xcd_barrier_post(unsigned* bar, volatile LAS unsigned* st) {
    XcdBarrier b; b.bar = bar; b.x = xb_xcc_id(); b.st = st;
    if (threadIdx.x == 0) (void)xb_add(&bar[XB_XCNT(b.x)], 1u);
    return b;
}
__device__ __forceinline__ void xcd_barrier_complete(unsigned* bar, unsigned x, unsigned& nloc, unsigned& nx) {
    const unsigned G = gridDim.x * gridDim.y * gridDim.z;
    unsigned sum, cnt, mine, sp = 0u;
    for (;;) {
        sum = 0u; cnt = 0u; mine = 0u;
#pragma unroll
        for (unsigned j = 0; j < 16; ++j) { const unsigned c = xb_ld(&bar[XB_XCNT(j)]); sum += c; cnt += (c > 0u) ? 1u : 0u; mine = (j == x) ? c : mine; }
        if (sum == G) break;
        __builtin_amdgcn_s_sleep(1);
        if ((++sp & 255u) == 0u) { if (xb_ld(&bar[XB_TMO])) break; if (sp > XB_SPIN_CAP) { atomicAdd(&bar[XB_TMO], 1u); break; } }
    }
    nloc = mine > 0u ? mine : 1u; nx = cnt > 0u ? cnt : 1u;
}

__device__ __attribute__((noinline)) void xcd_barrier(const XcdBarrier b, const bool leader_thread) {
    asm volatile("s_waitcnt vmcnt(0)" ::: "memory");
    __syncthreads();
    if (leader_thread) {
        unsigned* bar = b.bar;
        __builtin_amdgcn_s_waitcnt(0);
        unsigned nloc = b.st[0], nx = b.st[1];
        if (nloc == 0u) { xcd_barrier_complete(bar, b.x, nloc, nx); b.st[0] = nloc; b.st[1] = nx; }
        const unsigned old = xb_add(&bar[XB_XSUB(b.x)], 1u);
        const unsigned gen = old / nloc;
        if (old + 1u == (gen + 1u) * nloc) {
            __builtin_amdgcn_fence(__ATOMIC_RELEASE, "agent");
            asm volatile("s_waitcnt vmcnt(0)" ::: "memory");
            const unsigned og = xb_add(&bar[XB_TOP], 1u);
            const unsigned tg = og / nx;
            if (og + 1u == (tg + 1u) * nx) xb_add(&bar[XB_TOPGEN], 1u);
            else XB_SPIN(xb_ld(&bar[XB_TOPGEN]) == tg, bar);
            __builtin_amdgcn_fence(__ATOMIC_ACQUIRE, "agent");
            xb_add(&bar[XB_XGEN(b.x)], 1u);
            asm volatile("s_waitcnt vmcnt(0)" ::: "memory");
        } else {
            XB_SPIN(xb_ld(&bar[XB_XGEN(b.x)]) == gen, bar);
            __builtin_amdgcn_fence(__ATOMIC_ACQUIRE, "agent");
            asm volatile("s_waitcnt vmcnt(0)" ::: "memory");
        }
    }
    __syncthreads();
}

struct Ctx {
    LAS unsigned char* lds; unsigned char* ws; int tid, lane, wave, G, gw, NGW;
};

__device__ __forceinline__ void ph_prologue(KA p, const Ctx& c) {
    LAS float* sL = (LAS float*)c.lds;
    LAS float* red = (LAS float*)(c.lds + 9 * 1024 * 4);
    const float* cv = p->in[1]; const float* cc = p->in[3];
    for (int i = c.tid; i < 9 * 1024; i += 512) { const int bi = i >> 10, k = i & 1023; const float v = bi < 8 ? cv[bi * 1024 + k] : cc[k]; sL[i] = v * sigmoidf_(v); }
    __syncthreads();
    float* MOD = (float*)(c.ws + WS_MOD);
    for (int item = blockIdx.x; item < DEPTH * 96; item += c.G) {
        const int layer = item / 96, cg = item % 96, col = cg * 64 + c.lane;
        const float* W = p->in[4] + (size_t)layer * 1024 * 6144 + col;
        float acc[9];
#pragma unroll
        for (int bi = 0; bi < 9; ++bi) acc[bi] = 0.f;
#pragma unroll 8
        for (int kk = 0; kk < 128; ++kk) { const int k = c.wave * 128 + kk; const float w = __builtin_nontemporal_load(W + (size_t)k * 6144);
#pragma unroll
            for (int bi = 0; bi < 9; ++bi) acc[bi] += sL[bi * 1024 + k] * w; }
#pragma unroll
        for (int bi = 0; bi < 9; ++bi) red[(c.wave * 9 + bi) * 64 + c.lane] = acc[bi];
        __syncthreads();
        for (int i = c.tid; i < 576; i += 512) { const int bi = i >> 6, l = i & 63; float s = 0.f;
#pragma unroll
            for (int w = 0; w < 8; ++w) s += red[(w * 9 + bi) * 64 + l];
            MOD[(size_t)(layer * 9 + bi) * 6144 + cg * 64 + l] = s + p->in[5][layer * 6144 + cg * 64 + l]; }
        __syncthreads();
    }
    if (blockIdx.x == c.G - 1) {
        const int dr = c.tid >> 8, ch = c.tid & 255; const float* lg = p->in[9] + dr * DEPTH * 256 + ch;
        const float l0 = lg[0], l1 = lg[256], l2 = lg[512], l3 = lg[768]; const float mx = fmaxf(fmaxf(l0, l1), fmaxf(l2, l3));
        const float e0 = expf(l0 - mx), e1 = expf(l1 - mx), e2 = expf(l2 - mx), e3 = expf(l3 - mx), inv = 1.f / (e0 + e1 + e2 + e3);
        float* LB = (float*)(c.ws + WS_LB) + dr * DEPTH * 256 + ch;
        LB[0] = 0.f; LB[256] = e1 * inv; LB[512] = (e1 + e2) * inv; LB[768] = (e1 + e2 + e3) * inv;
    }
    if (blockIdx.x == c.G - 2) {
        const int pos = c.tid >> 3, fi = c.tid & 7;
        const float inv = exp2f(-(float)fi * 1.6609640474436813f);
        const float angf = (float)pos * inv;
        double r = (double)angf; const double TWO_PI = 6.283185307179586476925; r -= TWO_PI * __builtin_rint(r / TWO_PI);
        const double r2 = r * r; double cs = 1.0, sn = r, tc = 1.0, ts = r;
        for (int k = 1; k <= 14; ++k) { tc *= -r2 / (double)((2 * k - 1) * (2 * k)); ts *= -r2 / (double)((2 * k) * (2 * k + 1)); cs += tc; sn += ts; }
        float* RT = (float*)(c.ws + WS_ROPE); RT[c.tid * 2] = (float)cs; RT[c.tid * 2 + 1] = (float)sn;
    }
}

__device__ __forceinline__ void transpose_item(const float* W, int N, bf16* WT, int Kd, int k0, int n0, int drow0, LAS float* scr, int lane) {
    f32x4 wv[8];
#pragma unroll
    for (int i = 0; i < 8; ++i) wv[i] = __builtin_nontemporal_load((const f32x4*)(W + (size_t)(k0 + 8 * i + (lane >> 3)) * N + n0 + 4 * (lane & 7)));
#pragma unroll
    for (int i = 0; i < 8; ++i) { LAS float* d = scr + (8 * i + (lane >> 3)) * 33 + 4 * (lane & 7); d[0] = wv[i].x; d[1] = wv[i].y; d[2] = wv[i].z; d[3] = wv[i].w; }
    LDS_WAIT(); asm volatile("" ::: "memory");
    const int ch = lane & 7;
#pragma unroll
    for (int j = 0; j < 4; ++j) { const int n = (lane >> 3) + 8 * j; const LAS float* s = scr + (8 * ch) * 33 + n;
        v4u o; o.x = cvtpk(s[0 * 33], s[1 * 33]); o.y = cvtpk(s[2 * 33], s[3 * 33]); o.z = cvtpk(s[4 * 33], s[5 * 33]); o.w = cvtpk(s[6 * 33], s[7 * 33]);
        *(v4u*)(WT + (size_t)(drow0 + n) * Kd + k0 + 8 * ch) = o; }
    LDS_WAIT(); asm volatile("" ::: "memory");
}
__device__ __forceinline__ int rope_rho(int p) { return 16 * (p >> 4) + 8 * ((p >> 2) & 1) + 4 * ((p >> 3) & 1) + (p & 3); }

__device__ __forceinline__ void ph_convert(KA p, const Ctx& c, int layer) {
    LAS float* scr = (LAS float*)(c.lds + c.wave * 16384);
    constexpr int I_WIN = 16 * 89, I_WOUT = 16 * 32, I_EXP = 16 * 32;
    constexpr int NIT = I_WIN + I_WOUT + 3 * NE * I_EXP;
    bf16* WIN = (bf16*)(c.ws + WS_WIN); bf16* WOUT = (bf16*)(c.ws + WS_WOUT); bf16* W13 = (bf16*)(c.ws + WS_W13); bf16* W2 = (bf16*)(c.ws + WS_W2);
    for (int it = c.gw; it < NIT; it += c.NGW) {
        int r = it;
        if (r < I_WIN) { const int kb = r / 89, nb = r % 89, n0 = 32 * nb; transpose_item(p->in[8] + (size_t)layer * 1024 * 2848, 2848, WIN, 1024, 64 * kb, n0, n0 + (n0 >= 1696 ? 96 : 0), scr, c.lane); continue; }
        r -= I_WIN;
        if (r < I_WOUT) { const int kb = r >> 5, nb = r & 31; transpose_item(p->in[16] + (size_t)layer * 1024 * 1024, 1024, WOUT, 1024, 64 * kb, 32 * nb, 32 * nb, scr, c.lane); continue; }
        r -= I_WOUT;
        const int which = r / (NE * I_EXP); r -= which * (NE * I_EXP);
        const int e = r >> 9, rr = r & 511, kb = rr >> 5, nb = rr & 31, n0 = 32 * nb;
        const size_t woff = ((size_t)layer * NE + e) * 1024 * 1024;
        if (which == 0) transpose_item(p->in[18] + woff, 1024, W13 + (size_t)e * 2048 * 1024, 1024, 64 * kb, n0, 256 * (n0 >> 7) + (n0 & 127), scr, c.lane);
        else if (which == 1) transpose_item(p->in[19] + woff, 1024, W13 + (size_t)e * 2048 * 1024, 1024, 64 * kb, n0, 256 * (n0 >> 7) + 128 + (n0 & 127), scr, c.lane);
        else transpose_item(p->in[20] + woff, 1024, W2 + (size_t)e * 1024 * 1024, 1024, 64 * kb, n0, n0, scr, c.lane);
    }
    const int gt = blockIdx.x * 512 + c.tid, NGT = c.G * 512;
    for (int i = gt; i < 224 * 128; i += NGT) { const int rw = i >> 7, cq = i & 127; const int row = rw < 96 ? 1696 + rw : 2944 + (rw - 96);
        unsigned z = 0u; asm volatile("" : "+v"(z));
        *(v4u*)(WIN + (size_t)row * 1024 + cq * 8) = (v4u){z, z, z, z}; }
    bf16* WM = (bf16*)(c.ws + WS_WMLA);
    const float* wuq = p->in[12] + (size_t)layer * 256 * 576; const float* wukv = p->in[14] + (size_t)layer * 128 * 768;
    for (int i = gt; i < 1536 * 384; i += NGT) { const int n = i / 384, k = i - n * 384; float v = 0.f;
        if (n < 768) { const int h = n >> 7, ci = n & 127; if (ci < 96 && k < 256) { const int dim = ci < 64 ? ci : 64 + rope_rho(ci - 64); v = wuq[(size_t)k * 576 + h * 96 + dim]; } }
        else { if (k >= 256) v = wukv[(size_t)(k - 256) * 768 + (n - 768)]; }
        WM[i] = (bf16)f2bf(v); }
}

__device__ __forceinline__ void combine_row(const Ctx& c, int layer, int row, int bi, f32x4 (&v)[4], bool write_x) {
    const int* SEL = (const int*)(c.ws + WS_SEL); const float* GV = (const float*)(c.ws + WS_GV); const bf16* Y = (const bf16*)(c.ws + WS_Y);
    const float* gf = (const float*)(c.ws + WS_MOD) + (size_t)(layer * 9 + bi) * 6144 + 5120;
    const int sel = SEL[(size_t)row * 16 + (c.lane & 15)];
    f32x4 a[4];
#pragma unroll
    for (int j = 0; j < 4; ++j) a[j] = (f32x4){0.f, 0.f, 0.f, 0.f};
    unsigned mask = (unsigned)(__ballot(sel >= 0) & 0xffffull);
#pragma unroll 1
    while (mask) {
        const int e1 = __builtin_ctz(mask); mask &= mask - 1u; const bool two = mask != 0u; const int e2 = two ? __builtin_ctz(mask) : e1; mask &= mask - 1u;
        const int xs1 = __builtin_amdgcn_readlane(sel, e1), xs2 = __builtin_amdgcn_readlane(sel, e2);
        const float g1 = GV[xs1], g2 = two ? GV[xs2] : 0.f; const bf16* y1 = Y + (size_t)xs1 * 1024 + c.lane * 4; const bf16* y2 = Y + (size_t)xs2 * 1024 + c.lane * 4;
        v2u w1[4], w2[4];
#pragma unroll
        for (int j = 0; j < 4; ++j) { w1[j] = *(const v2u*)(y1 + 256 * j); w2[j] = *(const v2u*)(y2 + 256 * j); }
#pragma unroll
        for (int j = 0; j < 4; ++j) { a[j] += g1 * (f32x4){bf2f(w1[j].x & 0xffffu), bf2f(w1[j].x >> 16), bf2f(w1[j].y & 0xffffu), bf2f(w1[j].y >> 16)};
                                      a[j] += g2 * (f32x4){bf2f(w2[j].x & 0xffffu), bf2f(w2[j].x >> 16), bf2f(w2[j].y & 0xffffu), bf2f(w2[j].y >> 16)}; }
    }
    bf16* X = (bf16*)(c.ws + WS_X) + (size_t)row * 1024;
#pragma unroll
    for (int j = 0; j < 4; ++j) { const int col = c.lane * 4 + 256 * j; v[j] += *(const f32x4*)(gf + col) * a[j]; if (write_x) *(v2u*)(X + col) = (v2u){cvtpk(v[j].x, v[j].y), cvtpk(v[j].z, v[j].w)}; }
}

template <bool ROUTER, bool COMBINE, bool DRY = false>
__device__ __forceinline__ void ph_norm(KA p, const Ctx& c, int layer, const float* xlat, const float* xctx, int nrows) {
    const float* MOD = (const float*)(c.ws + WS_MOD) + (size_t)layer * 9 * 6144;
    const float* gain = (ROUTER ? p->in[7] : p->in[6]) + layer * 1024;
    const int o_sh = ROUTER ? 3072 : 0, o_sc = ROUTER ? 4096 : 1024;
    bf16* H = (bf16*)(c.ws + WS_H); float* AFF = (float*)(c.ws + WS_AFF);
    LAS float* RWT = (LAS float*)c.lds;
    if (ROUTER) { const float* rw = p->in[17] + (size_t)layer * 1024 * 16;
        for (int i = c.tid; i < 16384; i += 512) { const int col = i >> 4, e = i & 15; RWT[e * 1024 + col] = rw[i]; }
        __syncthreads(); }
    for (int row = c.gw; row < nrows; row += c.NGW) {
        asm volatile("" ::: "memory");
        const bf16* xr = (const bf16*)(c.ws + WS_X) + (size_t)row * 1024;
        const int bi = row < MLAT ? (row >> 12) : 8; const float* mp = MOD + bi * 6144;
        f32x4 v[4]; float ss = 0.f;
#pragma unroll
        for (int j = 0; j < 4; ++j) { const v2u w = *(const v2u*)(xr + c.lane * 4 + 256 * j); v[j] = (f32x4){bf2f(w.x & 0xffffu), bf2f(w.x >> 16), bf2f(w.y & 0xffffu), bf2f(w.y >> 16)}; }
        if (COMBINE) combine_row(c, layer - 1, row, bi, v, !DRY);
#pragma unroll
        for (int j = 0; j < 4; ++j) ss += (v[j].x * v[j].x + v[j].y * v[j].y) + (v[j].z * v[j].z + v[j].w * v[j].w);
        const float rstd = rsqrtf(wave_sum(ss) * (1.f / 1024.f) + EPS);
#pragma unroll
        for (int j = 0; j < 4; ++j) { const int col = c.lane * 4 + 256 * j;
            const f32x4 g = *(const f32x4*)(gain + col), sc = *(const f32x4*)(mp + o_sc + col), sh = *(const f32x4*)(mp + o_sh + col);
            v[j] = v[j] * rstd * g * (1.f + sc) + sh;
            *(v2u*)(H + (size_t)row * 1024 + col) = (v2u){cvtpk(v[j].x, v[j].y), cvtpk(v[j].z, v[j].w)}; }
        if (ROUTER) {
            float lg[16];
#pragma unroll
            for (int e = 0; e < 16; ++e) { float a = 0.f;
#pragma unroll
                for (int j = 0; j < 4; ++j) { const f32x4 w = *(const LAS f32x4*)(RWT + e * 1024 + c.lane * 4 + 256 * j); a += (v[j].x * w.x + v[j].y * w.y) + (v[j].z * w.z + v[j].w * w.w); }
                lg[e] = wave_sum(a); }
            float mx = lg[0];
#pragma unroll
            for (int e = 1; e < 16; ++e) mx = fmaxf(mx, lg[e]);
            float sm = 0.f;
#pragma unroll
            for (int e = 0; e < 16; ++e) { lg[e] = expf(lg[e] - mx); sm += lg[e]; }
            const float inv = 1.f / sm; float mine = 0.f;
#pragma unroll
            for (int e = 0; e < 16; ++e) mine = (c.lane == e) ? lg[e] * inv : mine;
            if (c.lane < 16) { AFF[(size_t)row * 16 + c.lane] = mine; ((int*)(c.ws + WS_SEL))[(size_t)row * 16 + c.lane] = -1; }
        }
    }
}

__device__ __forceinline__ float row16_sum_n(float v) { v += DPP_F(v, 0xB1); v += DPP_F(v, 0x4E); v += DPP_F(v, 0x141); v += DPP_F(v, 0x140); return v; }
template <bool ROUTER, bool XBF>
__device__ __forceinline__ void ph_norm4(KA p, const Ctx& c, int layer, const float* xlat, const float* xctx, int nrows) {
    const float* MODb = (const float*)(c.ws + WS_MOD) + (size_t)layer * 9 * 6144;
    const float* gain = (ROUTER ? p->in[7] : p->in[6]) + layer * 1024;
    const int o_sh = ROUTER ? 3072 : 0, o_sc = ROUTER ? 4096 : 1024;
    bf16* H = (bf16*)(c.ws + WS_H); float* AFF = (float*)(c.ws + WS_AFF); int* SEL = (int*)(c.ws + WS_SEL);
    LAS float* RWT = (LAS float*)c.lds;
    if (ROUTER) { const float* rw = p->in[17] + (size_t)layer * 1024 * 16;
        for (int i = c.tid; i < 16384; i += 512) { const int col = i >> 4, e = i & 15; RWT[e * 1024 + col] = rw[i]; }
        __syncthreads(); }
    const int g = c.lane >> 4, l16 = c.lane & 15;
    const int gpw = (nrows / 4 + c.NGW - 1) / c.NGW;
    for (int rb = c.gw * gpw * 4, re = min(nrows, (c.gw + 1) * gpw * 4); rb < re; rb += 4) {
        asm volatile("" ::: "memory");
        const int row = rb + g;
        const float* xr = (row < MLAT ? xlat + (size_t)row * 1024 : xctx + (size_t)(row - MLAT) * 1024) + 4 * l16;
        const bf16* xb = (const bf16*)(c.ws + WS_X) + (size_t)row * 1024 + 4 * l16;
        const int bi = rb < MLAT ? (rb >> 12) : 8;
        f32x4 v[16]; float ss = 0.f;
#pragma unroll
        for (int j = 0; j < 16; ++j) { if (XBF) { const v2u w = *(const v2u*)(xb + 64 * j); v[j] = (f32x4){bf2f(w.x & 0xffffu), bf2f(w.x >> 16), bf2f(w.y & 0xffffu), bf2f(w.y >> 16)}; } else v[j] = *(const f32x4*)(xr + 64 * j); }
#pragma unroll
        for (int j = 0; j < 16; ++j) ss += (v[j].x * v[j].x + v[j].y * v[j].y) + (v[j].z * v[j].z + v[j].w * v[j].w);
        const float rstd = rsqrtf(row16_sum_n(ss) * (1.f / 1024.f) + EPS);
        const float* mp = MODb + (size_t)bi * 6144 + 4 * l16;
#pragma unroll
        for (int j = 0; j < 16; ++j) { const int col = 4 * l16 + 64 * j;
            const f32x4 gg = *(const f32x4*)(gain + col), sc = *(const f32x4*)(mp + o_sc + 64 * j), sh = *(const f32x4*)(mp + o_sh + 64 * j);
            v[j] = v[j] * rstd * gg * (1.f + sc) + sh;
            *(v2u*)(H + (size_t)row * 1024 + col) = (v2u){cvtpk(v[j].x, v[j].y), cvtpk(v[j].z, v[j].w)}; }
        if (ROUTER) {
            float lg[16];
#pragma unroll
            for (int e = 0; e < 16; ++e) { float acc = 0.f;
#pragma unroll
                for (int j = 0; j < 16; ++j) { const f32x4 w = *(const LAS f32x4*)(RWT + e * 1024 + 4 * l16 + 64 * j); acc += (v[j].x * w.x + v[j].y * w.y) + (v[j].z * w.z + v[j].w * w.w); }
                lg[e] = row16_sum_n(acc); }
            float mx = lg[0];
#pragma unroll
            for (int e = 1; e < 16; ++e) mx = fmaxf(mx, lg[e]);
            float sm = 0.f;
#pragma unroll
            for (int e = 0; e < 16; ++e) { lg[e] = expf(lg[e] - mx); sm += lg[e]; }
            const float inv = 1.f / sm; float mine = 0.f;
#pragma unroll
            for (int e = 0; e < 16; ++e) mine = (l16 == e) ? lg[e] * inv : mine;
            AFF[(size_t)row * 16 + l16] = mine; SEL[(size_t)row * 16 + l16] = -1;
        }
    }
}

__device__ __forceinline__ void ph_final(KA p, const Ctx& c) {
    const bf16* X = (const bf16*)(c.ws + WS_X); const float* g = p->in[21];
    for (int row = c.gw; row < MLAT; row += c.NGW) {
        const bf16* xr = X + (size_t)row * 1024; f32x4 v[4]; float ss = 0.f;
#pragma unroll
        for (int j = 0; j < 4; ++j) { const v2u w = *(const v2u*)(xr + c.lane * 4 + 256 * j); v[j] = (f32x4){bf2f(w.x & 0xffffu), bf2f(w.x >> 16), bf2f(w.y & 0xffffu), bf2f(w.y >> 16)}; }
        combine_row(c, DEPTH - 1, row, row >> 12, v, false);
#pragma unroll
        for (int j = 0; j < 4; ++j) ss += (v[j].x * v[j].x + v[j].y * v[j].y) + (v[j].z * v[j].z + v[j].w * v[j].w);
        const float rstd = rsqrtf(wave_sum(ss) * (1.f / 1024.f) + EPS);
#pragma unroll
        for (int j = 0; j < 4; ++j) { const int col = c.lane * 4 + 256 * j; *(f32x4*)(p->out + (size_t)row * 1024 + col) = v[j] * rstd * *(const f32x4*)(g + col); }
    }
}

__device__ __forceinline__ void ph_mla_prep(KA p, const Ctx& c, int layer) {
    const bf16* P = (const bf16*)(c.ws + WS_P); bf16* AM = (bf16*)(c.ws + WS_AM); bf16* KM = (bf16*)(c.ws + WS_KM); const float* RT = (const float*)(c.ws + WS_ROPE);
    const float* gq = p->in[11] + layer * 256; const float* gkv = p->in[13] + layer * 128;
    const f32x4 g4 = *(const f32x4*)(gq + 4 * c.lane); const f32x2 g2 = *(const f32x2*)(gkv + 2 * c.lane);
    const int pp = c.lane & 31, fq = pp >> 3, n = (pp >> 2) & 1, i = pp & 3, half = fq >> 1, pair = 4 * (fq & 1) + i;
    constexpr int PB = 6;
#pragma unroll 1
    for (int row0 = c.gw; row0 < MALL; row0 += PB * c.NGW) {
        v2u qa[PB]; unsigned ka[PB]; unsigned short xa1[PB], xa2[PB]; f32x2 cs2[PB];
#pragma unroll
        for (int t = 0; t < PB; ++t) { const int row = row0 + t * c.NGW; if (row < MALL) { const bf16* pr = P + (size_t)row * NP;
            qa[t] = *(const v2u*)(pr + ML_CQ + 4 * c.lane); ka[t] = *(const unsigned*)(pr + ML_CKV + 2 * c.lane);
            xa1[t] = pr[ML_KR + 16 * half + pair]; xa2[t] = pr[ML_KR + 16 * half + 8 + pair];
            const int tk = row & 4095, pos = half ? (tk & 63) : (tk >> 6); cs2[t] = *(const f32x2*)(RT + (pos * 8 + pair) * 2); } }
#pragma unroll
        for (int t = 0; t < PB; ++t) { const int row = row0 + t * c.NGW; if (row < MALL) {
            const float q0 = bf2f(qa[t].x & 0xffffu), q1 = bf2f(qa[t].x >> 16), q2 = bf2f(qa[t].y & 0xffffu), q3 = bf2f(qa[t].y >> 16);
            const float rq = rsqrtf(wave_sum((q0 * q0 + q1 * q1) + (q2 * q2 + q3 * q3)) * (1.f / 256.f) + EPS);
            *(v2u*)(AM + (size_t)row * 384 + 4 * c.lane) = (v2u){cvtpk(q0 * rq * g4.x, q1 * rq * g4.y), cvtpk(q2 * rq * g4.z, q3 * rq * g4.w)};
            const float k0 = bf2f(ka[t] & 0xffffu), k1 = bf2f(ka[t] >> 16);
            const float rk = rsqrtf(wave_sum(k0 * k0 + k1 * k1) * (1.f / 128.f) + EPS);
            *(unsigned*)(AM + (size_t)row * 384 + 256 + 2 * c.lane) = cvtpk(k0 * rk * g2.x, k1 * rk * g2.y);
            if (c.lane < 32) {
                const float x1 = bf2f(xa1[t]), x2 = bf2f(xa2[t]);
                int b, kvi; float val;
                if (row < MLAT) { b = row >> 12; kvi = row & 4095; const float cs = cs2[t].x, sn = cs2[t].y; val = n ? (x2 * cs + x1 * sn) : (x1 * cs - x2 * sn); }
                else { const int rr = row - MLAT; b = rr >> 8; kvi = T + (rr & 255); val = n ? x2 : x1; }
                const bf16 vb = (bf16)f2bf(val); const int tile = kvi >> 6, kvr = kvi & 63;
#pragma unroll
                for (int h = 0; h < 6; ++h) KM[((size_t)((b * 6 + h) * NKT + tile) * 12 + 8 + fq) * 512 + kvr * 8 + (pp & 7)] = vb;
            } } }
    }
}

__device__ __forceinline__ int hg_row(int b, int cnat, int i) { return cnat < 4 ? MLAT + b * 256 + cnat * 64 + i : b * T + (cnat - 4) * 64 + i; }

__device__ __forceinline__ void ph_hgrn_pass1(KA p, const Ctx& c, int layer) {
    const bf16* P = (const bf16*)(c.ws + WS_P); float* HU = (float*)(c.ws + WS_HU); float* HD = (float*)(c.ws + WS_HD); const float* LB = (const float*)(c.ws + WS_LB);
    LAS float* fL = (LAS float*)(c.lds + c.wave * 16384); LAS float* kL = fL + 1024; LAS float* vL = fL + 2048;
    for (int item = c.gw; item < 64 * NHS; item += c.NGW) {
        const int seq = item / NHS, s = item - seq * NHS, dir = seq & 1, h = (seq >> 1) & 3, b = seq >> 3;
        const int cnat = dir ? (s < 4 ? 3 - s : 71 - s) : s;
        const float lbv = LB[(dir * DEPTH + layer) * 256 + h * 64 + c.lane];
        const int zcol = (dir ? HG_ZB : HG_ZF) + h * 64 + c.lane, vcol = HG_I + h * 64 + c.lane;
        float U[64];
#pragma unroll
        for (int d = 0; d < 64; ++d) U[d] = 0.f;
        float Dp = 1.f;
#pragma unroll 1
        for (int sb = 0; sb < 4; ++sb) {
#pragma unroll 4
            for (int tt = 0; tt < 16; ++tt) { const int i = sb * 16 + tt; const size_t ro = (size_t)hg_row(b, cnat, dir ? 63 - i : i) * NP;
                const float z = bf2f(P[ro + zcol]); const float f = fmaxf(lbv + (1.f - lbv) * sigmoidf_(z), 1e-20f);
                fL[tt * 64 + c.lane] = f; kL[tt * 64 + c.lane] = 1.f - f; vL[tt * 64 + c.lane] = bf2f(P[ro + vcol]); Dp *= f; }
            LDS_WAIT();
#pragma unroll 1
            for (int tt = 0; tt < 16; ++tt) { const float v = vL[tt * 64 + c.lane];
#pragma unroll
                for (int d4 = 0; d4 < 16; ++d4) { const f32x4 f4 = *(const LAS f32x4*)(fL + tt * 64 + d4 * 4), k4 = *(const LAS f32x4*)(kL + tt * 64 + d4 * 4);
                    U[4 * d4 + 0] = f4.x * U[4 * d4 + 0] + k4.x * v; U[4 * d4 + 1] = f4.y * U[4 * d4 + 1] + k4.y * v;
                    U[4 * d4 + 2] = f4.z * U[4 * d4 + 2] + k4.z * v; U[4 * d4 + 3] = f4.w * U[4 * d4 + 3] + k4.w * v; } }
            LDS_WAIT();
        }
        float* uo = HU + ((size_t)seq * NKT + s) * 4096 + c.lane;
#pragma unroll
        for (int d = 0; d < 64; ++d) uo[d * 64] = U[d];
        HD[((size_t)seq * NKT + s) * 64 + c.lane] = Dp;
    }
}

__device__ __forceinline__ void ph_hgrn_scan(const Ctx& c) {
    float* HU = (float*)(c.ws + WS_HU); const float* HD = (const float*)(c.ws + WS_HD);
    for (int el = blockIdx.x * 512 + c.tid; el < 64 * 4096; el += c.G * 512) {
        const int seq = el >> 12, de = el & 4095, d = de >> 6; float S = 0.f;
#pragma unroll 4
        for (int s = 0; s < NHS; ++s) { const size_t o = ((size_t)seq * NKT + s) * 4096 + de; const float u = HU[o], dc = HD[((size_t)seq * NKT + s) * 64 + d]; HU[o] = S; S = dc * S + u; }
        HU[((size_t)seq * NKT + NHS) * 4096 + de] = S;
    }
}

__device__ __forceinline__ void ph_hgrn_pass3(KA p, const Ctx& c, int layer, bool with_ctx) {
    const bf16* P = (const bf16*)(c.ws + WS_P); const float* HU = (const float*)(c.ws + WS_HU); const float* LB = (const float*)(c.ws + WS_LB);
    float* OF = (float*)(c.ws + WS_OF); bf16* MIX = (bf16*)(c.ws + WS_MIX);
    LAS float* fL = (LAS float*)(c.lds + c.wave * 16384); LAS float* kL = fL + 1024; LAS float* vL = fL + 2048; LAS float* qL = fL + 3072;
    const float og = p->in[10][layer * 64 + c.lane];
    const int c0 = with_ctx ? 0 : 4, nper = NKT - c0;
    for (int item = c.gw; item < 32 * nper; item += c.NGW) {
        const int bh = item / nper, cnat = c0 + (item - bh * nper), h = bh & 3, b = bh >> 2;
#pragma unroll 1
        for (int dir = 0; dir < 2; ++dir) {
            const int seq = bh * 2 + dir, s = dir ? (cnat < 4 ? 3 - cnat : 71 - cnat) : cnat;
            const float lbv = LB[(dir * DEPTH + layer) * 256 + h * 64 + c.lane];
            const int zcol = (dir ? HG_ZB : HG_ZF) + h * 64 + c.lane, vcol = HG_I + h * 64 + c.lane, qcol = HG_Q + h * 64 + c.lane, gcol = HG_G + h * 64 + c.lane;
            float S[64]; const float* si = HU + ((size_t)seq * NKT + s) * 4096 + c.lane;
#pragma unroll
            for (int d = 0; d < 64; ++d) S[d] = si[d * 64];
#pragma unroll 1
            for (int sb = 0; sb < 4; ++sb) {
#pragma unroll 4
                for (int tt = 0; tt < 16; ++tt) { const int i = sb * 16 + tt; const size_t ro = (size_t)hg_row(b, cnat, dir ? 63 - i : i) * NP;
                    const float z = bf2f(P[ro + zcol]); const float f = fmaxf(lbv + (1.f - lbv) * sigmoidf_(z), 1e-20f);
                    fL[tt * 64 + c.lane] = f; kL[tt * 64 + c.lane] = 1.f - f; vL[tt * 64 + c.lane] = bf2f(P[ro + vcol]); qL[tt * 64 + c.lane] = bf2f(P[ro + qcol]) * 0.125f; }
                LDS_WAIT();
#pragma unroll 1
                for (int tt = 0; tt < 16; ++tt) { const float v = vL[tt * 64 + c.lane]; float o0 = 0.f, o1 = 0.f;
#pragma unroll
                    for (int d4 = 0; d4 < 16; ++d4) { const f32x4 f4 = *(const LAS f32x4*)(fL + tt * 64 + d4 * 4), k4 = *(const LAS f32x4*)(kL + tt * 64 + d4 * 4), q4 = *(const LAS f32x4*)(qL + tt * 64 + d4 * 4);
                        S[4 * d4 + 0] = f4.x * S[4 * d4 + 0] + k4.x * v; S[4 * d4 + 1] = f4.y * S[4 * d4 + 1] + k4.y * v;
                        S[4 * d4 + 2] = f4.z * S[4 * d4 + 2] + k4.z * v; S[4 * d4 + 3] = f4.w * S[4 * d4 + 3] + k4.w * v;
                        o0 += q4.x * S[4 * d4 + 0] + q4.z * S[4 * d4 + 2]; o1 += q4.y * S[4 * d4 + 1] + q4.w * S[4 * d4 + 3]; }
                    const float o = o0 + o1; const int i = sb * 16 + tt; const int row = hg_row(b, cnat, dir ? 63 - i : i);
                    if (dir == 0) OF[(size_t)row * 256 + h * 64 + c.lane] = o;
                    else { const float tot = o + OF[(size_t)row * 256 + h * 64 + c.lane];
                        const float y = tot * rsqrtf(wave_sum(tot * tot) * (1.f / 64.f) + EPS) * og; const float g = bf2f(P[(size_t)row * NP + gcol]);
                        MIX[(size_t)row * 1024 + h * 64 + c.lane] = (bf16)f2bf(y * g * sigmoidf_(g)); } }
                LDS_WAIT();
            }
        }
    }
}

__device__ __forceinline__ void ph_attn_mla_simple(const Ctx& c, bool with_ctx) {
    const bf16* QM = (const bf16*)(c.ws + WS_QM); const bf16* KM = (const bf16*)(c.ws + WS_KM); const bf16* VM = (const bf16*)(c.ws + WS_VM); bf16* MIX = (bf16*)(c.ws + WS_MIX);
    const int nq = with_ctx ? NQK : T;
    for (int item = c.gw; item < 48 * nq; item += c.NGW) {
        const int bh = item / nq, qi = item - bh * nq, b = bh / 6, h = bh - b * 6; const bool isctx = qi >= T;
        float q[96];
#pragma unroll
        for (int ch = 0; ch < 12; ++ch) unpack8(*(const v4u*)(QM + ((size_t)bh * NQK + qi) * 96 + ch * 8), q + ch * 8);
        float m = -1e30f, l = 0.f, o = 0.f;
#pragma unroll 1
        for (int tile = isctx ? 64 : 0; tile < NKT; ++tile) {
            const bf16* kb = KM + (size_t)(bh * NKT + tile) * 12 * 512 + c.lane * 8; float s = 0.f;
#pragma unroll
            for (int ch = 0; ch < 12; ++ch) { float kk[8]; unpack8(*(const v4u*)(kb + ch * 512), kk);
#pragma unroll
                for (int i = 0; i < 8; ++i) s += q[ch * 8 + i] * kk[i]; }
            const float mn = fmaxf(m, wave_max(s)), pj = exp2f(s - mn), corr = exp2f(m - mn);
            l = l * corr + wave_sum(pj); o *= corr; m = mn;
            const bf16* vb = VM + (size_t)(bh * NKT + tile) * 2 * 2048 + (c.lane >> 5) * 2048 + (c.lane & 31);
#pragma unroll 8
            for (int j = 0; j < 64; ++j) o += rdlane(pj, j) * bf2f(vb[j * 32]);
        }
        const int row = isctx ? MLAT + b * 256 + (qi - T) : b * T + qi;
        MIX[(size_t)row * 1024 + 256 + h * 64 + c.lane] = (bf16)f2bf(o / l);
    }
}
__device__ __forceinline__ void ph_attn_na_simple(KA p, const Ctx& c, int layer, bool with_ctx) {
    const bf16* P = (const bf16*)(c.ws + WS_P); bf16* MIX = (bf16*)(c.ws + WS_MIX); const float* rpb = p->in[15] + (size_t)layer * 6 * 15 * 31;
    const int nq = with_ctx ? NQK : T;
    for (int item = c.gw; item < 48 * nq; item += c.NGW) {
        const int bh = item / nq, qi = item - bh * nq, b = bh / 6, h = bh - b * 6; const bool isctx = qi >= T;
        const int qrow = isctx ? MLAT + b * 256 + (qi - T) : b * T + qi;
        float q[64];
#pragma unroll
        for (int ch = 0; ch < 8; ++ch) unpack8(*(const v4u*)(P + (size_t)qrow * NP + NA_Q + h * 64 + ch * 8), q + ch * 8);
        const int r = qi >> 6, cc = qi & 63; const int rs = min(max(r - 4, 0), 56), cs = min(max(cc - 8, 0), 48);
        float m = -1e30f, l = 0.f, o = 0.f;
#pragma unroll 1
        for (int chunk = isctx ? 2 : 0; chunk < 6; ++chunk) {
            int krow; float bias = 0.f;
            if (chunk < 2) { const int w = chunk * 64 + c.lane, wr = w >> 4, wc = w & 15; krow = b * T + (rs + wr) * 64 + cs + wc; bias = rpb[(h * 15 + (rs + wr - r + 7)) * 31 + (cs + wc - cc + 15)]; }
            else krow = MLAT + b * 256 + (chunk - 2) * 64 + c.lane;
            const bf16* kb = P + (size_t)krow * NP + NA_K + h * 64; float s = 0.f;
#pragma unroll
            for (int ch = 0; ch < 8; ++ch) { float kk[8]; unpack8(*(const v4u*)(kb + ch * 8), kk);
#pragma unroll
                for (int i = 0; i < 8; ++i) s += q[ch * 8 + i] * kk[i]; }
            s = s * NA_QS + bias * LOG2E;
            const float mn = fmaxf(m, wave_max(s)), pj = exp2f(s - mn), corr = exp2f(m - mn);
            l = l * corr + wave_sum(pj); o *= corr; m = mn;
#pragma unroll 8
            for (int j = 0; j < 64; ++j) { int vrow; if (chunk < 2) { const int w = chunk * 64 + j; vrow = b * T + (rs + (w >> 4)) * 64 + cs + (w & 15); } else vrow = MLAT + b * 256 + (chunk - 2) * 64 + j;
                o += rdlane(pj, j) * bf2f(P[(size_t)vrow * NP + NA_V + h * 64 + c.lane]); }
        }
        MIX[(size_t)qrow * 1024 + 640 + h * 64 + c.lane] = (bf16)f2bf(o / l);
    }
}

__device__ __forceinline__ void ph_topk(const Ctx& c, bool with_ctx) {
    const float* AFF = (const float*)(c.ws + WS_AFF); const bf16* H = (const bf16*)(c.ws + WS_H); bf16* XS = (bf16*)(c.ws + WS_XS);
    float* GV = (float*)(c.ws + WS_GV);
    LAS unsigned* keys = (LAS unsigned*)c.lds;
    LAS unsigned* hist = keys + 4096;
    LAS unsigned* tot = hist + 2048;
    LAS unsigned* res = tot + 256;
    LAS unsigned* wtot = res + 16;
    LAS int* selL = (LAS int*)(wtot + 16);
    const int nitems = with_ctx ? 256 : 128;
    for (int item = blockIdx.x; item < nitems; item += c.G) {
        const bool lat = item < 128; const int be = lat ? item : item - 128, b = be >> 4, e = be & 15;
        const int ntok = lat ? T : NC, cap = lat ? CAPL : CAPC, rowbase = lat ? b * T : MLAT + b * NC, xs0 = lat ? be * CAPL : XS_LAT + (e * NB + b) * CAPC;
        const int per = lat ? 8 : 1;
        for (int i = c.tid; i < ntok; i += 512) keys[i] = __float_as_uint(AFF[(size_t)(rowbase + i) * 16 + e]);
        __syncthreads();
        unsigned prefix = 0u, rem = (unsigned)cap;
#pragma unroll 1
        for (int rd = 0; rd < 4; ++rd) {
            const int shift = 24 - 8 * rd; const unsigned himask = rd ? (0xffffffffu << (shift + 8)) : 0u;
            for (int i = c.tid; i < 2048; i += 512) hist[i] = 0u;
            __syncthreads();
            for (int i = c.tid; i < ntok; i += 512) { const unsigned k = keys[i]; if ((k & himask) == prefix) atomicAdd((unsigned*)(hist + c.wave * 256 + ((k >> shift) & 255u)), 1u); }
            __syncthreads();
            if (c.tid < 256) { unsigned t = 0u;
#pragma unroll
                for (int w = 0; w < 8; ++w) t += hist[w * 256 + c.tid];
                tot[c.tid] = t; }
            __syncthreads();
            if (c.wave == 0) { const unsigned t0 = tot[4 * c.lane], t1 = tot[4 * c.lane + 1], t2 = tot[4 * c.lane + 2], t3 = tot[4 * c.lane + 3];
                const unsigned incl = wave_incl_scan_u(t0 + t1 + t2 + t3, c.lane); const unsigned total = (unsigned)__builtin_amdgcn_readlane((int)incl, 63);
                const unsigned ab3 = total - incl, ab2 = ab3 + t3, ab1 = ab2 + t2, ab0 = ab1 + t1;
                if (ab3 < rem && rem <= ab3 + t3) { res[0] = 4 * c.lane + 3; res[1] = ab3; }
                if (ab2 < rem && rem <= ab2 + t2) { res[0] = 4 * c.lane + 2; res[1] = ab2; }
                if (ab1 < rem && rem <= ab1 + t1) { res[0] = 4 * c.lane + 1; res[1] = ab1; }
                if (ab0 < rem && rem <= ab0 + t0) { res[0] = 4 * c.lane; res[1] = ab0; } }
            __syncthreads();
            prefix |= res[0] << shift; rem -= res[1];
        }
        const unsigned ngt = (unsigned)cap - rem, need = rem;
        unsigned mycnt = 0;
        if (c.tid * per < ntok) for (int j = 0; j < per; ++j) { const unsigned k = keys[c.tid * per + j]; mycnt += (k > prefix) ? 1u : 0u; mycnt += (k == prefix) ? 0x10000u : 0u; }
        const unsigned incl = wave_incl_scan_u(mycnt, c.lane);
        if (c.lane == 63) wtot[c.wave] = incl;
        __syncthreads();
        unsigned base = 0;
#pragma unroll
        for (int w = 0; w < 8; ++w) base += (w < c.wave) ? wtot[w] : 0u;
        unsigned excl = base + incl - mycnt; unsigned pg = excl & 0xffffu, pe = excl >> 16;
        if (c.tid * per < ntok) for (int j = 0; j < per; ++j) { const int i = c.tid * per + j; const unsigned k = keys[i]; int slot = -1;
            if (k > prefix) slot = (int)pg++; else if (k == prefix) { if (pe < need) slot = (int)(ngt + pe); ++pe; }
            if (slot >= 0) { ((int*)(c.ws + WS_IDX))[xs0 + slot] = rowbase + i; GV[xs0 + slot] = __uint_as_float(k); ((int*)(c.ws + WS_SEL))[(size_t)(rowbase + i) * 16 + e] = xs0 + slot; } }
        __syncthreads();
        __syncthreads();
    }
}
typedef short bf16x8_t __attribute__((ext_vector_type(8)));
typedef short s16x4_t __attribute__((ext_vector_type(4)));
typedef float f32x16_t __attribute__((ext_vector_type(16)));
__device__ __forceinline__ int crow(int r, int hi) { return (r & 3) + 8 * (r >> 2) + 4 * hi; }
__device__ __forceinline__ float max3f(float a, float b, float c) { float r; asm("v_max3_f32 %0, %1, %2, %3" : "=v"(r) : "v"(a), "v"(b), "v"(c)); return r; }
#define MAX32(P0, P1) fmaxf(max3f(max3f(max3f(max3f(max3f(max3f(max3f(fmaxf(P0[0], P1[0]), P0[1], P1[1]), P0[2], P1[2]), P0[3], P1[3]), P0[4], P1[4]), P0[5], P1[5]), P0[6], P1[6]), P0[7], P1[7]), \
                            max3f(max3f(max3f(max3f(max3f(max3f(max3f(fmaxf(P0[8], P1[8]), P0[9], P1[9]), P0[10], P1[10]), P0[11], P1[11]), P0[12], P1[12]), P0[13], P1[13]), P0[14], P1[14]), P0[15], P1[15]))
__device__ __forceinline__ s16x4_t vtr16(const LAS unsigned char* p) { return __builtin_bit_cast(s16x4_t, __builtin_amdgcn_ds_read_tr16_b64_v4i16((LAS s16x4_t*)p)); }
__device__ __forceinline__ float half_swap_max(float m) { auto rr = __builtin_amdgcn_permlane32_swap(__float_as_uint(m), __float_as_uint(m), false, false); return fmaxf(__uint_as_float(rr[0]), __uint_as_float(rr[1])); }
__device__ __forceinline__ float half_swap_sum(float m) { auto rr = __builtin_amdgcn_permlane32_swap(__float_as_uint(m), __float_as_uint(m), false, false); return __uint_as_float(rr[0]) + __uint_as_float(rr[1]); }

#define MLA_TILE(kbuf, vbuf, first) do { \
    f32x16_t p0 = {}, p1 = {}; \
    const LAS unsigned char* kb = (kbuf) + hi * 1024 + r32 * 16; \
    _Pragma("unroll") for (int d0 = 0; d0 < 6; ++d0) { const bf16x8_t b0 = *(const LAS bf16x8_t*)(kb + d0 * 2048), b1 = *(const LAS bf16x8_t*)(kb + d0 * 2048 + 512); \
        p0 = __builtin_amdgcn_mfma_f32_32x32x16_bf16(b0, qr[d0], p0, 0, 0, 0); p1 = __builtin_amdgcn_mfma_f32_32x32x16_bf16(b1, qr[d0], p1, 0, 0, 0); } \
    float mx = fmaxf(p0[0], p1[0]); \
    _Pragma("unroll") for (int r = 1; r < 16; ++r) mx = fmaxf(mx, fmaxf(p0[r], p1[r])); \
    mx = half_swap_max(mx); \
    if (first) mref = mx; \
    else if (__any(mx > mref + 8.f)) { \
        const float dl = fmaxf(mx - mref, 0.f); mref += dl; const float f = __builtin_amdgcn_exp2f(-dl); l *= f; \
        if (hi == 0) wsf[r32] = f; \
        LDS_WAIT(); \
        _Pragma("unroll") for (int r = 0; r < 16; ++r) { const float fr = wsf[crow(r, hi)]; o0[r] *= fr; o1[r] *= fr; } \
        LDS_WAIT(); } \
    float sacc = 0.f; \
    _Pragma("unroll") for (int r = 0; r < 16; ++r) { p0[r] = __builtin_amdgcn_exp2f(p0[r] - mref); p1[r] = __builtin_amdgcn_exp2f(p1[r] - mref); sacc += p0[r] + p1[r]; } \
    l += sacc; \
    v4u pw[4]; \
    pw[0] = (v4u){cvtpk(p0[0], p0[1]), cvtpk(p0[2], p0[3]), cvtpk(p0[4], p0[5]), cvtpk(p0[6], p0[7])}; \
    pw[1] = (v4u){cvtpk(p0[8], p0[9]), cvtpk(p0[10], p0[11]), cvtpk(p0[12], p0[13]), cvtpk(p0[14], p0[15])}; \
    pw[2] = (v4u){cvtpk(p1[0], p1[1]), cvtpk(p1[2], p1[3]), cvtpk(p1[4], p1[5]), cvtpk(p1[6], p1[7])}; \
    pw[3] = (v4u){cvtpk(p1[8], p1[9]), cvtpk(p1[10], p1[11]), cvtpk(p1[12], p1[13]), cvtpk(p1[14], p1[15])}; \
    const LAS unsigned char* vp = (vbuf) + ((lane >> 4) & 1) * 32 + (lane & 3) * 8 + (4 * hi + ((lane & 15) >> 2)) * 64; \
    _Pragma("unroll") for (int ks = 0; ks < 4; ++ks) { \
        const s16x4_t a0 = vtr16(vp + ks * 1024), a1 = vtr16(vp + ks * 1024 + 512), b0 = vtr16(vp + 4096 + ks * 1024), b1 = vtr16(vp + 4096 + ks * 1024 + 512); \
        const bf16x8_t va = (bf16x8_t){a0[0], a0[1], a0[2], a0[3], a1[0], a1[1], a1[2], a1[3]}, vb = (bf16x8_t){b0[0], b0[1], b0[2], b0[3], b1[0], b1[1], b1[2], b1[3]}; \
        const bf16x8_t pa = __builtin_bit_cast(bf16x8_t, pw[ks]); \
        o0 = __builtin_amdgcn_mfma_f32_32x32x16_bf16(pa, va, o0, 0, 0, 0); o1 = __builtin_amdgcn_mfma_f32_32x32x16_bf16(pa, vb, o1, 0, 0, 0); } \
  } while (0)

__device__ __forceinline__ void ph_attn_mla(const Ctx& c, bool with_ctx) {
    const bf16* QM = (const bf16*)(c.ws + WS_QM); const bf16* KM = (const bf16*)(c.ws + WS_KM); const bf16* VM = (const bf16*)(c.ws + WS_VM); bf16* MIX = (bf16*)(c.ws + WS_MIX);
    const int tid = c.tid, lane = c.lane, r32 = lane & 31, hi = lane >> 5, wid = c.wave;
    LAS unsigned char* ring = c.lds;
    LAS float* wsf = (LAS float*)(c.lds + 81920) + wid * 128;
    const int vcu = (blockIdx.x & 7) * (c.G >> 3) + (blockIdx.x >> 3);
    const int nunits = 768 + (with_ctx ? 48 : 0);
#pragma unroll 1
    for (int L = vcu; L < nunits; L += c.G) {
        int bh, q0, t0, np;
        if (L < 768) { bh = L >> 4; q0 = (L & 15) * 256; t0 = 0; np = NKT / 2; } else { bh = L - 768; q0 = T; t0 = 64; np = 2; }
        const bf16* qp = QM + ((size_t)bh * NQK + q0 + wid * 32 + r32) * 96 + hi * 8;
        bf16x8_t qr[6];
#pragma unroll
        for (int d0 = 0; d0 < 6; ++d0) qr[d0] = *(const bf16x8_t*)(qp + d0 * 16);
        const unsigned char* kt = (const unsigned char*)(KM + (size_t)(bh * NKT + t0) * 6144);
        const unsigned char* vt = (const unsigned char*)(VM + (size_t)(bh * NKT + t0) * 4096);
        const unsigned char* sp[5]; size_t sst[5];
#pragma unroll
        for (int k = 0; k < 5; ++k) { const int pc = tid + 512 * k; const bool isk = pc < 1536; sp[k] = isk ? kt + pc * 16 : vt + (pc - 1536) * 16; sst[k] = isk ? 24576 : 16384; }
        v4u rr[5];
#pragma unroll
        for (int k = 0; k < 5; ++k) rr[k] = *(const v4u*)sp[k];
        float mref = 0.f, l = 0.f; f32x16_t o0 = {}, o1 = {};
#pragma unroll 1
        for (int it = 0; it < np; ++it) {
            LAS unsigned char* buf = ring + (it & 1) * 40960;
#pragma unroll
            for (int k = 0; k < 5; ++k) *(LAS v4u*)(buf + (tid + 512 * k) * 16) = rr[k];
            __syncthreads();
            if (it + 1 < np) {
#pragma unroll
                for (int k = 0; k < 5; ++k) rr[k] = *(const v4u*)(sp[k] + (size_t)(it + 1) * sst[k]); }
            MLA_TILE(buf, buf + 24576, it == 0);
            MLA_TILE(buf + 12288, buf + 24576 + 8192, false);
        }
        l = half_swap_sum(l);
        if (hi == 0) wsf[32 + r32] = l;
        LDS_WAIT();
        const int b = bh / 6, h = bh - b * 6;
        const int rowbase = (L < 768 ? b * T + q0 : MLAT + b * NC) + wid * 32;
#pragma unroll
        for (int r = 0; r < 16; ++r) { const int qq = crow(r, hi); const float rl = __builtin_amdgcn_rcpf(wsf[32 + qq]); bf16* op = MIX + (size_t)(rowbase + qq) * 1024 + 256 + h * 64 + r32;
            op[0] = (bf16)f2bf(o0[r] * rl); op[32] = (bf16)f2bf(o1[r] * rl); }
        LDS_WAIT();
        __syncthreads();
    }
}

#define SBAR0() __builtin_amdgcn_sched_barrier(0)
#define KFRAG(base, g) (*(const LAS bf16x8_t*)((base) + ((g) >> 1) * 2048 + ((g) & 1) * 512))
#define VLO(base, g) vtr16((base) + ((g) & 1) * 4096 + ((g) >> 1) * 1024)
#define VHI(base, g) vtr16((base) + ((g) & 1) * 4096 + ((g) >> 1) * 1024 + 512)
#define PACK4(P, B) (v4u){cvtpk(P[B], P[B + 1]), cvtpk(P[B + 2], P[B + 3]), cvtpk(P[B + 4], P[B + 5]), cvtpk(P[B + 6], P[B + 7])}
#define EXP4(P, B) do { _Pragma("unroll") for (int e_ = 0; e_ < 4; ++e_) { P[(B) + e_] = __builtin_amdgcn_exp2f(P[(B) + e_] - mref); sacc += P[(B) + e_]; } } while (0)
#define VF8(g) (bf16x8_t){vl[(g) & 3][0], vl[(g) & 3][1], vl[(g) & 3][2], vl[(g) & 3][3], vh[(g) & 3][0], vh[(g) & 3][1], vh[(g) & 3][2], vh[(g) & 3][3]}
#define RESCALE(mxv) do { const float dl_ = fmaxf((mxv) - mref, 0.f); mref += dl_; const float f_ = __builtin_amdgcn_exp2f(-dl_); l *= f_; \
        if (hi == 0) wsf[r32] = f_; LDS_WAIT(); \
        _Pragma("unroll") for (int r = 0; r < 16; ++r) { const float fr_ = wsf[crow(r, hi)]; o0[r] *= fr_; o1[r] *= fr_; } LDS_WAIT(); } while (0)
__device__ __forceinline__ void ph_attn_mla2(const Ctx& c, bool with_ctx) {
    const bf16* QM = (const bf16*)(c.ws + WS_QM); const bf16* KM = (const bf16*)(c.ws + WS_KM); const bf16* VM = (const bf16*)(c.ws + WS_VM); bf16* MIX = (bf16*)(c.ws + WS_MIX);
    const int tid = c.tid, lane = c.lane, r32 = lane & 31, hi = lane >> 5, wid = c.wave;
    LAS unsigned char* ring = c.lds;
    LAS float* wsf = (LAS float*)(c.lds + 81920) + wid * 128;
    const int vcu = (blockIdx.x & 7) * (c.G >> 3) + (blockIdx.x >> 3);
    const int cxu = (c.G == 256) ? (((int)(blockIdx.x >> 3) >= 26) ? (int)(blockIdx.x & 7) * 6 + (int)(blockIdx.x >> 3) - 26 : -1) : (vcu < 48 ? vcu : -1);
    const int nunits = 768 + (with_ctx ? 48 : 0);
    const int nmine = c.G == 256 ? 3 + ((with_ctx && cxu >= 0) ? 1 : 0) : (vcu < nunits ? (nunits - vcu + c.G - 1) / c.G : 0);
    const int koff = hi * 1024 + r32 * 16, voff = ((lane >> 4) & 1) * 32 + (lane & 3) * 8 + (4 * hi + ((lane & 15) >> 2)) * 64;
#pragma unroll 1
    for (int ui = 0; ui < nmine; ++ui) {
        const int L = (c.G != 256 || ui < 3) ? vcu + ui * c.G : 768 + cxu;
        int bh, q0, t0, np;
        if (L < 768) { bh = L >> 4; q0 = (L & 15) * 256; t0 = 0; np = NKT / 2; } else { bh = L - 768; q0 = T; t0 = 64; np = 2; }
        const bf16* qp = QM + ((size_t)bh * NQK + q0 + wid * 32 + r32) * 96 + hi * 8;
        bf16x8_t qr[6];
#pragma unroll
        for (int d0 = 0; d0 < 6; ++d0) qr[d0] = *(const bf16x8_t*)(qp + d0 * 16);
        const unsigned char* kt = (const unsigned char*)(KM + (size_t)(bh * NKT + t0) * 6144);
        const unsigned char* vt = (const unsigned char*)(VM + (size_t)(bh * NKT + t0) * 4096);
#define MLA_DMA(itn, slot) do { _Pragma("unroll") for (int k_ = 0; k_ < 5; ++k_) { const int pc_ = wid + 8 * k_; \
            const unsigned char* src_ = (pc_ < 24 ? kt + (size_t)(itn) * 24576 + pc_ * 1024 : vt + (size_t)(itn) * 16384 + (pc_ - 24) * 1024) + lane * 16; \
            __builtin_amdgcn_global_load_lds((const unsigned*)src_, (LAS unsigned*)(ring + (slot) * 40960 + pc_ * 1024), 16, 0, 0); } } while (0)
        MLA_DMA(0, 0);
        float mref = 0.f, l = 0.f; f32x16_t o0 = {}, o1 = {};
#pragma unroll 1
        for (int it = 0; it < np; ++it) {
            LAS unsigned char* buf = ring + (it & 1) * 40960;
            asm volatile("s_waitcnt vmcnt(0)" ::: "memory");
            __syncthreads();
            if (it + 1 < np) MLA_DMA(it + 1, (it + 1) & 1);
            const LAS unsigned char* ka = buf + koff; const LAS unsigned char* kb = buf + 12288 + koff;
            const LAS unsigned char* va = buf + 24576 + voff; const LAS unsigned char* vb = buf + 32768 + voff;
            bf16x8_t kf[6]; s16x4_t vl[4], vh[4];
#pragma unroll
            for (int g = 0; g < 6; ++g) kf[g] = KFRAG(ka, g);
            f32x16_t pa0 = {}, pa1 = {};
#pragma unroll
            for (int g = 0; g < 12; ++g) {
                if (g & 1) pa1 = __builtin_amdgcn_mfma_f32_32x32x16_bf16(kf[g % 6], qr[g >> 1], pa1, 0, 0, 0); else pa0 = __builtin_amdgcn_mfma_f32_32x32x16_bf16(kf[g % 6], qr[g >> 1], pa0, 0, 0, 0);
                if (g < 6) kf[g % 6] = KFRAG(ka, g + 6); else kf[g % 6] = KFRAG(kb, g - 6);
                SBAR0(); }
            float mx = MAX32(pa0, pa1);
            mx = half_swap_max(mx);
            if (it == 0) mref = mx; else if (__any(mx > mref + 8.f)) RESCALE(mx);
            f32x16_t pb0 = {}, pb1 = {}; float sacc = 0.f; v4u pwa[4];
            SBAR0();
#pragma unroll
            for (int g = 0; g < 12; ++g) {
                if (g & 1) pb1 = __builtin_amdgcn_mfma_f32_32x32x16_bf16(kf[g % 6], qr[g >> 1], pb1, 0, 0, 0); else pb0 = __builtin_amdgcn_mfma_f32_32x32x16_bf16(kf[g % 6], qr[g >> 1], pb0, 0, 0, 0);
                if (g < 6) kf[g % 6] = KFRAG(kb, g + 6);
                if (g >= 8) { vl[g - 8] = VLO(va, g - 8); vh[g - 8] = VHI(va, g - 8); }
                if (g < 4) EXP4(pa0, 4 * g); else if (g < 8) EXP4(pa1, 4 * (g - 4));
                else if (g == 8) pwa[0] = PACK4(pa0, 0); else if (g == 9) pwa[1] = PACK4(pa0, 8); else if (g == 10) pwa[2] = PACK4(pa1, 0); else pwa[3] = PACK4(pa1, 8);
                SBAR0(); }
            l += sacc;
            float mxb = MAX32(pb0, pb1);
            mxb = half_swap_max(mxb);
            const bool rescb = __any(mxb > mref + 8.f);
            sacc = 0.f; v4u pwb[4];
            SBAR0();
#pragma unroll
            for (int g = 0; g < 8; ++g) {
                const bf16x8_t vf = VF8(g); const bf16x8_t pf = __builtin_bit_cast(bf16x8_t, pwa[g >> 1]);
                if (g & 1) o1 = __builtin_amdgcn_mfma_f32_32x32x16_bf16(pf, vf, o1, 0, 0, 0); else o0 = __builtin_amdgcn_mfma_f32_32x32x16_bf16(pf, vf, o0, 0, 0, 0);
                if (g < 4) { vl[g & 3] = VLO(va, g + 4); vh[g & 3] = VHI(va, g + 4); } else { vl[g & 3] = VLO(vb, g - 4); vh[g & 3] = VHI(vb, g - 4); }
                if (!rescb) { if (g < 4) EXP4(pb0, 4 * g); else EXP4(pb1, 4 * (g - 4));
                    if (g == 1) pwb[0] = PACK4(pb0, 0); else if (g == 3) pwb[1] = PACK4(pb0, 8); else if (g == 5) pwb[2] = PACK4(pb1, 0); else if (g == 7) pwb[3] = PACK4(pb1, 8); }
                SBAR0(); }
            if (rescb) { RESCALE(mxb);
#pragma unroll
                for (int g = 0; g < 4; ++g) { EXP4(pb0, 4 * g); EXP4(pb1, 4 * g); }
                pwb[0] = PACK4(pb0, 0); pwb[1] = PACK4(pb0, 8); pwb[2] = PACK4(pb1, 0); pwb[3] = PACK4(pb1, 8); }
            l += sacc;
#pragma unroll
            for (int g = 0; g < 8; ++g) {
                const bf16x8_t vf = VF8(g); const bf16x8_t pf = __builtin_bit_cast(bf16x8_t, pwb[g >> 1]);
                if (g & 1) o1 = __builtin_amdgcn_mfma_f32_32x32x16_bf16(pf, vf, o1, 0, 0, 0); else o0 = __builtin_amdgcn_mfma_f32_32x32x16_bf16(pf, vf, o0, 0, 0, 0);
                if (g < 4) { vl[g & 3] = VLO(vb, g + 4); vh[g & 3] = VHI(vb, g + 4); }
                SBAR0(); }
        }
        l = half_swap_sum(l);
        if (hi == 0) wsf[32 + r32] = l;
        LDS_WAIT();
        const int b = bh / 6, h = bh - b * 6;
        const int rowbase = (L < 768 ? b * T + q0 : MLAT + b * NC) + wid * 32;
#pragma unroll
        for (int r = 0; r < 16; ++r) { const int qq = crow(r, hi); const float rl = __builtin_amdgcn_rcpf(wsf[32 + qq]); bf16* op = MIX + (size_t)(rowbase + qq) * 1024 + 256 + h * 64 + r32;
            op[0] = (bf16)f2bf(o0[r] * rl); op[32] = (bf16)f2bf(o1[r] * rl); }
        LDS_WAIT();
        __syncthreads();
    }
}
__device__ __forceinline__ void ph_attn_na(KA p, const Ctx& c, int layer, bool with_ctx) {
    const bf16* P = (const bf16*)(c.ws + WS_P); bf16* MIX = (bf16*)(c.ws + WS_MIX);
    const int tid = c.tid, lane = c.lane, r32 = lane & 31, hi = lane >> 5, wid = c.wave;
    LAS unsigned char* ring = c.lds;
    LAS float* wsf = (LAS float*)(c.lds + 32768) + wid * 128;
    LAS float* rpbL = (LAS float*)(c.lds + 32768 + 4096);
    const int vcu = (blockIdx.x & 7) * (c.G >> 3) + (blockIdx.x >> 3);
    const int skv = tid >> 3, sch = tid & 7;
    constexpr int HG_WAVES = 6;
    const int n2 = 32 * (NKT - (with_ctx ? 0 : 4)) - c.G * HG_WAVES;
    int ustart = vcu, ucount = 3, ustride = c.G;
    if (c.G == 256) { const int x = blockIdx.x & 7, j = blockIdx.x >> 3;
        int nA = 0; for (int jj = 0; jj < 32; ++jj) nA += ((8 * jj + x) * HG_WAVES < n2) ? 1 : 0;
        const int nB = 32 - nA, k4 = 96 - 2 * nA - 3 * nB;
        if (k4 >= 0 && k4 <= nB) { ustride = 1;
            if (j < nA) { ustart = 96 * x + 2 * j; ucount = 2; }
            else { const int jb = j - nA; ustart = 96 * x + 2 * nA + (jb < k4 ? 4 * jb : 4 * k4 + 3 * (jb - k4)); ucount = jb < k4 ? 4 : 3; } } }
    const int cxu = (c.G == 256) ? (((int)(blockIdx.x >> 3) >= 26) ? (int)(blockIdx.x & 7) * 6 + (int)(blockIdx.x >> 3) - 26 : -1) : (vcu < 48 ? vcu : -1);
    const int nunits = 768 + (with_ctx ? 48 : 0);
    const int nlat = ustride == 1 ? ucount : 3, nmine = c.G == 256 ? nlat + ((with_ctx && cxu >= 0) ? 1 : 0) : (vcu < nunits ? (nunits - vcu + c.G - 1) / c.G : 0);
    int hprev = -1;
#pragma unroll 1
    for (int ui = 0; ui < nmine; ++ui) {
        const int L = (c.G != 256 || ui < nlat) ? ustart + ui * ustride : 768 + cxu;
        const bool lat = L < 768; const int bh = lat ? (L >> 4) : (L - 768), b = bh / 6, h = bh - b * 6, r0 = lat ? (L & 15) * 4 : 0;
        const int krlo = min(max(r0 - 4, 0), 56), nkr = lat ? (min(max(r0 + 3 - 4, 0), 56) + 8 - krlo) : 0, ntile = nkr + 4;
        const int rq = r0 + (wid >> 1), cq = 32 * (wid & 1) + r32, rsq = min(max(rq - 4, 0), 56), cs = min(max(cq - 8, 0), 48);
        const int qrow = lat ? b * T + rq * 64 + cq : MLAT + b * NC + wid * 32 + r32;
        bf16x8_t qr[4];
#pragma unroll
        for (int d0 = 0; d0 < 4; ++d0) qr[d0] = *(const bf16x8_t*)(P + (size_t)qrow * NP + NA_Q + h * 64 + d0 * 16 + hi * 8);
        const size_t hoff = (size_t)h * 64 + sch * 8;
#define NA_TOK(it) ((it) < nkr ? b * T + (krlo + (it)) * 64 + skv : MLAT + b * NC + ((it) - nkr) * 64 + skv)
#define NA_DMA(it, slot) do { const int t_ = (it); \
            const int tk_ = t_ < nkr ? b * T + (krlo + t_) * 64 + lane : MLAT + b * NC + (t_ - nkr) * 64 + lane; \
            const int tv_ = t_ < nkr ? b * T + (krlo + t_) * 64 + 16 * (wid & 3) + (lane >> 2) : MLAT + b * NC + (t_ - nkr) * 64 + 16 * (wid & 3) + (lane >> 2); \
            __builtin_amdgcn_global_load_lds((const unsigned*)(P + (size_t)tk_ * NP + NA_K + h * 64 + wid * 8), (LAS unsigned*)(ring + (slot) * 16384 + wid * 1024), 16, 0, 0); \
            __builtin_amdgcn_global_load_lds((const unsigned*)(P + (size_t)tv_ * NP + NA_V + h * 64 + (wid >> 2) * 32 + (lane & 3) * 8), (LAS unsigned*)(ring + (slot) * 16384 + 8192 + wid * 1024), 16, 0, 0); } while (0)
        NA_DMA(0, 0);
        if (h != hprev) { const float* rp = p->in[15] + ((size_t)layer * 6 + h) * 465; for (int i = tid; i < 465; i += 512) rpbL[i] = rp[i] * LOG2E; hprev = h; }
        float mref = 0.f, l = 0.f; f32x16_t o0 = {}, o1 = {}; bool started = false;
#pragma unroll 1
        for (int it = 0; it < ntile; ++it) {
            LAS unsigned char* buf = ring + (it & 1) * 16384;
            asm volatile("s_waitcnt vmcnt(0)" ::: "memory");
            __syncthreads();
            if (it + 1 < ntile) NA_DMA(it + 1, (it + 1) & 1);
            const bool win = it < nkr; const int kr = krlo + it;
            if (win && (kr < rsq || kr > rsq + 7)) continue;
#define NA_TILE(WIN, A0, A1, B0, B1, KS0, KS1) do { \
            f32x16_t p0 = {}, p1 = {}; \
            const LAS unsigned char* kb = buf + hi * 1024 + r32 * 16; \
            _Pragma("unroll") for (int d0 = 0; d0 < 4; ++d0) { const bf16x8_t b0 = *(const LAS bf16x8_t*)(kb + d0 * 2048), b1 = *(const LAS bf16x8_t*)(kb + d0 * 2048 + 512); \
                p0 = __builtin_amdgcn_mfma_f32_32x32x16_bf16(b0, qr[d0], p0, 0, 0, 0); p1 = __builtin_amdgcn_mfma_f32_32x32x16_bf16(b1, qr[d0], p1, 0, 0, 0); } \
            if (WIN) { const LAS float* bp = rpbL + (kr - rq + 7) * 31 + 15 - cq; \
                _Pragma("unroll") for (int r = A0; r < A1; ++r) { const int k0 = crow(r, hi); p0[r] = (k0 >= cs && k0 < cs + 16) ? p0[r] * NA_QS + bp[k0] : -INFINITY; } \
                _Pragma("unroll") for (int r = B0; r < B1; ++r) { const int k1 = 32 + crow(r, hi); p1[r] = (k1 >= cs && k1 < cs + 16) ? p1[r] * NA_QS + bp[k1] : -INFINITY; } } \
            else { _Pragma("unroll") for (int r = 0; r < 16; ++r) { p0[r] *= NA_QS; p1[r] *= NA_QS; } } \
            float mx = -INFINITY; \
            _Pragma("unroll") for (int r = A0; r < A1; ++r) mx = fmaxf(mx, p0[r]); \
            _Pragma("unroll") for (int r = B0; r < B1; ++r) mx = fmaxf(mx, p1[r]); \
            mx = half_swap_max(mx); \
            if (!started) { mref = mx; started = true; } \
            else if (__any(mx > mref + 8.f)) { \
                const float dl = fmaxf(mx - mref, 0.f); mref += dl; const float f = __builtin_amdgcn_exp2f(-dl); l *= f; \
                if (hi == 0) wsf[r32] = f; \
                LDS_WAIT(); \
                _Pragma("unroll") for (int r = 0; r < 16; ++r) { const float fr = wsf[crow(r, hi)]; o0[r] *= fr; o1[r] *= fr; } \
                LDS_WAIT(); \
            } \
            float sacc = 0.f; \
            _Pragma("unroll") for (int r = 0; r < 16; ++r) { if (r >= A0 && r < A1) { p0[r] = __builtin_amdgcn_exp2f(p0[r] - mref); sacc += p0[r]; } else p0[r] = 0.f; \
                                                             if (r >= B0 && r < B1) { p1[r] = __builtin_amdgcn_exp2f(p1[r] - mref); sacc += p1[r]; } else p1[r] = 0.f; } \
            l += sacc; \
            v4u pw[4]; \
            pw[0] = (v4u){cvtpk(p0[0], p0[1]), cvtpk(p0[2], p0[3]), cvtpk(p0[4], p0[5]), cvtpk(p0[6], p0[7])}; \
            pw[1] = (v4u){cvtpk(p0[8], p0[9]), cvtpk(p0[10], p0[11]), cvtpk(p0[12], p0[13]), cvtpk(p0[14], p0[15])}; \
            pw[2] = (v4u){cvtpk(p1[0], p1[1]), cvtpk(p1[2], p1[3]), cvtpk(p1[4], p1[5]), cvtpk(p1[6], p1[7])}; \
            pw[3] = (v4u){cvtpk(p1[8], p1[9]), cvtpk(p1[10], p1[11]), cvtpk(p1[12], p1[13]), cvtpk(p1[14], p1[15])}; \
            const LAS unsigned char* vp = buf + 8192 + ((lane >> 4) & 1) * 32 + (lane & 3) * 8 + (4 * hi + ((lane & 15) >> 2)) * 64; \
            _Pragma("unroll") for (int ks = KS0; ks < KS1; ++ks) { \
                const s16x4_t a0 = vtr16(vp + ks * 1024), a1 = vtr16(vp + ks * 1024 + 512), b0 = vtr16(vp + 4096 + ks * 1024), b1 = vtr16(vp + 4096 + ks * 1024 + 512); \
                const bf16x8_t va = (bf16x8_t){a0[0], a0[1], a0[2], a0[3], a1[0], a1[1], a1[2], a1[3]}, vb = (bf16x8_t){b0[0], b0[1], b0[2], b0[3], b1[0], b1[1], b1[2], b1[3]}; \
                const bf16x8_t pa = __builtin_bit_cast(bf16x8_t, pw[ks]); \
                o0 = __builtin_amdgcn_mfma_f32_32x32x16_bf16(pa, va, o0, 0, 0, 0); o1 = __builtin_amdgcn_mfma_f32_32x32x16_bf16(pa, vb, o1, 0, 0, 0); } } while (0)
            if (!win) NA_TILE(false, 0, 16, 0, 16, 0, 4);
            else if ((wid & 1) == 0) NA_TILE(true, 0, 16, 0, 4, 0, 3);
            else NA_TILE(true, 12, 16, 0, 16, 1, 4);
#undef NA_TILE
        }
#undef NA_TOK
        l = half_swap_sum(l);
        if (hi == 0) wsf[32 + r32] = l;
        LDS_WAIT();
        const int rowbase = lat ? b * T + rq * 64 + 32 * (wid & 1) : MLAT + b * NC + wid * 32;
#pragma unroll
        for (int r = 0; r < 16; ++r) { const int qq = crow(r, hi); const float rl = __builtin_amdgcn_rcpf(wsf[32 + qq]); bf16* op = MIX + (size_t)(rowbase + qq) * 1024 + 640 + h * 64 + r32;
            op[0] = (bf16)f2bf(o0[r] * rl); op[32] = (bf16)f2bf(o1[r] * rl); }
        LDS_WAIT();
        __syncthreads();
    }
}
constexpr int HG_BP = 68, HG_BL_BYTES = 65 * HG_BP * 4, HG_WAVE_BYTES = HG_BL_BYTES + 8192, HG_WAVES = 6;
constexpr int HG1_WAVES = 4;
static_assert(HG_WAVES == 6, "the neighbourhood-attention unit deal assumes six HGRN waves per workgroup");
__device__ __forceinline__ float exp_c(float x) { return __builtin_amdgcn_exp2f(fminf(x, 115.f)); }
__device__ __forceinline__ unsigned pk_bf(float a, float b) { return cvtpk(a, b); }
__device__ __forceinline__ f32x2 ex2(f32x2 x) { return (f32x2){__builtin_amdgcn_exp2f(x.x), __builtin_amdgcn_exp2f(x.y)}; }
__device__ __forceinline__ f32x2 mn2(f32x2 x, float c) { return (f32x2){fminf(x.x, c), fminf(x.y, c)}; }
__device__ __forceinline__ unsigned pk_bf2(f32x2 v) { return cvtpk(v.x, v.y); }
__device__ __forceinline__ unsigned kt2(f32x2 bj, f32x2 bp, f32x2 r) { return pk_bf2(((f32x2){1.f, 1.f} - ex2(bj - bp)) * ex2(mn2(r - bj, 115.f))); }
__device__ __forceinline__ unsigned qt2(unsigned qpair, f32x2 bi, f32x2 r3) { return pk_bf2((f32x2){bf2f(qpair & 0xffffu), bf2f(qpair >> 16)} * ex2(mn2(bi - r3, 112.f))); }
__device__ __forceinline__ float sigm_fast(float z) { return __builtin_amdgcn_rcpf(1.f + __builtin_amdgcn_exp2f(-z * LOG2E)); }

#define HG_LOAD_V(vr, row0) _Pragma("unroll") for (int k_ = 0; k_ < 8; ++k_) { const int idx_ = lane_l + 64 * k_; vr[k_] = *(const v4u*)(P + (size_t)((row0) + (idx_ >> 3)) * NP + HG_I + h * 64 + (idx_ & 7) * 8); }
#define HG_STORE_V(vr) _Pragma("unroll") for (int k_ = 0; k_ < 8; ++k_) { const int idx_ = lane_l + 64 * k_, tok_ = idx_ >> 3, ch_ = idx_ & 7; *(LAS v4u*)(vimg + (ch_ >> 2) * 4096 + tok_ * 64 + (ch_ & 3) * 16) = vr[k_]; }
__device__ __forceinline__ void hg_cumsum(const bf16* P, LAS float* bL, int row0, int dir, int h, float lbv, int lane) {
    const int zcol = (dir ? HG_ZB : HG_ZF) + h * 64 + lane;
    unsigned short zr[64];
    { unsigned zb = (unsigned)(row0 * NP + zcol) * 2u; asm volatile("" : "+v"(zb));
      const char* Pb = (const char*)P;
#pragma unroll
      for (int i = 0; i < 64; ++i) { zr[i] = *(const bf16*)(Pb + zb); zb += (unsigned)NP * 2u; } }
    float acc = 0.f;
    if (dir == 0) { bL[lane] = 0.f;
#pragma unroll
        for (int i = 0; i < 64; ++i) { const float f = fmaxf(lbv + (1.f - lbv) * sigm_fast(bf2f(zr[i])), 1e-20f); acc += __builtin_amdgcn_logf(f); bL[(i + 1) * HG_BP + lane] = acc; } }
    else { bL[64 * HG_BP + lane] = 0.f;
#pragma unroll
        for (int i = 63; i >= 0; --i) { const float f = fmaxf(lbv + (1.f - lbv) * sigm_fast(bf2f(zr[i])), 1e-20f); acc += __builtin_amdgcn_logf(f); bL[i * HG_BP + lane] = acc; } }
    LDS_WAIT(); asm volatile("" ::: "memory");
}

__device__ __forceinline__ void ph_hgrn1_mfma(KA p, const Ctx& c, int layer) {
    if (c.wave >= HG1_WAVES) return;
    const bf16* P = (const bf16*)(c.ws + WS_P); float* HU = (float*)(c.ws + WS_HU); float* HD = (float*)(c.ws + WS_HD); const float* LB = (const float*)(c.ws + WS_LB);
    LAS float* bL = (LAS float*)(c.lds + c.wave * HG_WAVE_BYTES); LAS unsigned char* vimg = c.lds + c.wave * HG_WAVE_BYTES + HG_BL_BYTES;
    const int lane = c.lane, r32 = lane & 31, hi = lane >> 5;
#pragma unroll 1
    for (int item = blockIdx.x * HG1_WAVES + c.wave; item < 32 * NKT; item += c.G * HG1_WAVES) {
        const int bh = item / NKT, cnat = item - bh * NKT, h = bh & 3, b = bh >> 2, row0 = hg_row(b, cnat, 0);
        int lane_l = lane; asm volatile("" : "+v"(lane_l));
        v4u vr[8]; HG_LOAD_V(vr, row0); HG_STORE_V(vr);
        const LAS unsigned char* vpn = vimg + ((lane >> 4) & 1) * 32 + (lane & 3) * 8 + (8 * hi + ((lane & 15) >> 2)) * 64;
#pragma unroll 1
        for (int dir = 0; dir < 2; ++dir) {
            const int seq = bh * 2 + dir, s = dir ? (cnat < 4 ? 3 - cnat : 71 - cnat) : cnat;
            if (s >= NHS) continue;
            hg_cumsum(P, bL, row0, dir, h, LB[(dir * DEPTH + layer) * 256 + h * 64 + lane], lane);
            const int rb = 1 - dir, rp = dir, rend = dir ? 0 : 64;
            f32x16_t u[2][2] = {};
            {
                const LAS float* bc = bL + (8 * hi + rb) * HG_BP + r32; const LAS float* bv = bL + (8 * hi + rp) * HG_BP + r32;
                const f32x2 bend2 = {bL[rend * HG_BP + r32], bL[rend * HG_BP + 32 + r32]};
#pragma unroll
                for (int j0 = 0; j0 < 4; ++j0) { float kb0[8], kb1[8];
#pragma unroll
                    for (int jj = 0; jj < 8; ++jj) { const int n = 16 * j0 + jj;
                        const f32x2 cur = {bc[n * HG_BP], bc[n * HG_BP + 32]}, prev = {bv[n * HG_BP], bv[n * HG_BP + 32]};
                        const f32x2 kv = ((f32x2){1.f, 1.f} - ex2(cur - prev)) * ex2(bend2 - cur);
                        kb0[jj] = kv.x; kb1[jj] = kv.y; }
                    const bf16x8_t ka0 = __builtin_bit_cast(bf16x8_t, (v4u){pk_bf(kb0[0], kb0[1]), pk_bf(kb0[2], kb0[3]), pk_bf(kb0[4], kb0[5]), pk_bf(kb0[6], kb0[7])});
                    const bf16x8_t ka1 = __builtin_bit_cast(bf16x8_t, (v4u){pk_bf(kb1[0], kb1[1]), pk_bf(kb1[2], kb1[3]), pk_bf(kb1[4], kb1[5]), pk_bf(kb1[6], kb1[7])});
#pragma unroll
                    for (int eh = 0; eh < 2; ++eh) { const s16x4_t a0 = vtr16(vpn + eh * 4096 + j0 * 1024), a1 = vtr16(vpn + eh * 4096 + j0 * 1024 + 256);
                        const bf16x8_t vb = (bf16x8_t){a0[0], a0[1], a0[2], a0[3], a1[0], a1[1], a1[2], a1[3]};
                        u[0][eh] = __builtin_amdgcn_mfma_f32_32x32x16_bf16(ka0, vb, u[0][eh], 0, 0, 0); u[1][eh] = __builtin_amdgcn_mfma_f32_32x32x16_bf16(ka1, vb, u[1][eh], 0, 0, 0); } } }
            bf16* uo = (bf16*)HU + ((size_t)seq * NKT + s) * 4096;
#pragma unroll
            for (int dh = 0; dh < 2; ++dh)
#pragma unroll
                for (int eh = 0; eh < 2; ++eh)
#pragma unroll
                    for (int g = 0; g < 4; ++g) *(v2u*)(uo + (32 * eh + r32) * 64 + 32 * dh + 8 * g + 4 * hi) = (v2u){pk_bf(u[dh][eh][4 * g], u[dh][eh][4 * g + 1]), pk_bf(u[dh][eh][4 * g + 2], u[dh][eh][4 * g + 3])};
            HD[((size_t)seq * NKT + s) * 64 + lane] = __builtin_amdgcn_exp2f(bL[rend * HG_BP + lane]);
            LDS_WAIT(); asm volatile("" ::: "memory");
        }
    }
}

__device__ __forceinline__ void ph_hgrn_scan_t(const Ctx& c, bool dummy = false) {
    unsigned* HUp = (unsigned*)(c.ws + WS_HU); const float* HD = (const float*)(c.ws + WS_HD); const size_t ooff = dummy ? (size_t)(826 * MiB - WS_HU) / 4 : 0;
    for (int el = blockIdx.x * 512 + c.tid; el < 64 * 2048; el += c.G * 512) {
        const int seq = el >> 11, pr = el & 2047, d = (pr & 31) * 2; float S0 = 0.f, S1 = 0.f;
        unsigned* hu = HUp + (size_t)seq * NKT * 2048 + pr; const float* hd = HD + (size_t)seq * NKT * 64 + d;
#pragma unroll 1
        for (int s0 = 0; s0 < NHS; s0 += 34) {
            unsigned uu[34]; f32x2 dd[34];
#pragma unroll
            for (int i = 0; i < 34; ++i) if (s0 + i < NHS) { uu[i] = hu[(size_t)(s0 + i) * 2048]; dd[i] = *(const f32x2*)(hd + (s0 + i) * 64); }
#pragma unroll
            for (int i = 0; i < 34; ++i) if (s0 + i < NHS) { hu[ooff + (size_t)(s0 + i) * 2048] = pk_bf(S0, S1); S0 = dd[i].x * S0 + bf2f(uu[i] & 0xffffu); S1 = dd[i].y * S1 + bf2f(uu[i] >> 16); }
        }
        hu[ooff + (size_t)NHS * 2048] = pk_bf(S0, S1);
    }
}

__device__ __forceinline__ void ph_hgrn3_mfma(KA p, const Ctx& c, int layer, bool with_ctx) {
    if (c.wave >= HG_WAVES) return;
    const bf16* P = (const bf16*)(c.ws + WS_P); const float* HU = (const float*)(c.ws + WS_HU); const float* LB = (const float*)(c.ws + WS_LB); bf16* MIX = (bf16*)(c.ws + WS_MIX);
    LAS float* bL = (LAS float*)(c.lds + c.wave * HG_WAVE_BYTES); LAS unsigned char* vimg = c.lds + c.wave * HG_WAVE_BYTES + HG_BL_BYTES;
    const int lane = c.lane, r32 = lane & 31, hi = lane >> 5;
    const int c0 = with_ctx ? 0 : 4, nper = NKT - c0;
    const LAS unsigned char* vp = vimg + ((lane >> 4) & 1) * 32 + (lane & 3) * 8 + (4 * hi + ((lane & 15) >> 2)) * 64;
#pragma unroll 1
    for (int item = blockIdx.x * HG_WAVES + c.wave; item < 32 * nper; item += c.G * HG_WAVES) {
        const int bh = item / nper, cnat = c0 + (item - bh * nper), h = bh & 3, b = bh >> 2, row0 = hg_row(b, cnat, 0);
        int lane_l = lane; asm volatile("" : "+v"(lane_l));
        v4u vr[8]; HG_LOAD_V(vr, row0);
        v4u qp0[4], qp1[4];
#pragma unroll
        for (int d0 = 0; d0 < 4; ++d0) { qp0[d0] = *(const v4u*)(P + (size_t)(row0 + r32) * NP + HG_Q + h * 64 + 16 * d0 + 8 * hi); qp1[d0] = *(const v4u*)(P + (size_t)(row0 + 32 + r32) * NP + HG_Q + h * 64 + 16 * d0 + 8 * hi); }
        HG_STORE_V(vr);
        f32x16_t o00 = {}, o01 = {}, o10 = {}, o11 = {};
#pragma unroll 1
        for (int dir = 0; dir < 2; ++dir) {
            const int seq = bh * 2 + dir, s = dir ? (cnat < 4 ? 3 - cnat : 71 - cnat) : cnat;
            const bf16* S0 = (const bf16*)HU + ((size_t)seq * NKT + s) * 4096;
            bf16x8_t sfr[4][2];
#pragma unroll
            for (int d0 = 0; d0 < 4; ++d0)
#pragma unroll
                for (int eh = 0; eh < 2; ++eh) sfr[d0][eh] = *(const bf16x8_t*)(S0 + (32 * eh + r32) * 64 + 16 * d0 + 8 * hi);
            hg_cumsum(P, bL, row0, dir, h, LB[(dir * DEPTH + layer) * 256 + h * 64 + lane], lane);
            const int rb = 1 - dir, rp = dir;
#pragma unroll 1
            for (int I = 0; I < 2; ++I) {
                const int ti = 32 * I + r32;
#pragma unroll
                for (int d0 = 0; d0 < 4; ++d0) { const int dd = 16 * d0 + 8 * hi; float qv[8]; unpack8(qp0[d0], qv);
                    const f32x4 b0 = *(const LAS f32x4*)(bL + (ti + rb) * HG_BP + dd), b1 = *(const LAS f32x4*)(bL + (ti + rb) * HG_BP + dd + 4);
                    const f32x4 m3 = {-3.f, -3.f, -3.f, -3.f}; const f32x4 c0 = b0 + m3, c1 = b1 + m3;
                    const bf16x8_t qa = __builtin_bit_cast(bf16x8_t, (v4u){pk_bf2((f32x2){qv[0], qv[1]} * ex2(c0.lo)), pk_bf2((f32x2){qv[2], qv[3]} * ex2(c0.hi)), pk_bf2((f32x2){qv[4], qv[5]} * ex2(c1.lo)), pk_bf2((f32x2){qv[6], qv[7]} * ex2(c1.hi))});
#pragma unroll
                    for (int eh = 0; eh < 2; ++eh) { const bf16x8_t sb = sfr[d0][eh];
                        if (eh) o01 = __builtin_amdgcn_mfma_f32_32x32x16_bf16(qa, sb, o01, 0, 0, 0); else o00 = __builtin_amdgcn_mfma_f32_32x32x16_bf16(qa, sb, o00, 0, 0, 0); }
                    __builtin_amdgcn_sched_barrier(0); }
#pragma unroll 1
                for (int J = dir ? I : 0; J <= (dir ? 1 : I); ++J) {
                    const int refrow = (I == J) ? (32 * I + 16) : 32;
                    const int tj = 32 * J + r32;
                    f32x16_t x = {};
#pragma unroll
                    for (int d0 = 0; d0 < 4; ++d0) { const int dd = 16 * d0 + 8 * hi;
                        const f32x4 r0 = *(const LAS f32x4*)(bL + refrow * HG_BP + dd), r1 = *(const LAS f32x4*)(bL + refrow * HG_BP + dd + 4);
                        const f32x4 bj0 = *(const LAS f32x4*)(bL + (tj + rb) * HG_BP + dd), bj1 = *(const LAS f32x4*)(bL + (tj + rb) * HG_BP + dd + 4);
                        const f32x4 bp0 = *(const LAS f32x4*)(bL + (tj + rp) * HG_BP + dd), bp1 = *(const LAS f32x4*)(bL + (tj + rp) * HG_BP + dd + 4);
                        const bf16x8_t ka = __builtin_bit_cast(bf16x8_t, (v4u){kt2(bj0.lo, bp0.lo, r0.lo), kt2(bj0.hi, bp0.hi, r0.hi), kt2(bj1.lo, bp1.lo, r1.lo), kt2(bj1.hi, bp1.hi, r1.hi)});
                        const f32x4 bi0 = *(const LAS f32x4*)(bL + (ti + rb) * HG_BP + dd), bi1 = *(const LAS f32x4*)(bL + (ti + rb) * HG_BP + dd + 4);
                        const f32x4 p3 = {3.f, 3.f, 3.f, 3.f}; const f32x4 r30 = r0 + p3, r31 = r1 + p3;
                        const v4u qw = qp0[d0];
                        const bf16x8_t qb = __builtin_bit_cast(bf16x8_t, (v4u){qt2(qw.x, bi0.lo, r30.lo), qt2(qw.y, bi0.hi, r30.hi), qt2(qw.z, bi1.lo, r31.lo), qt2(qw.w, bi1.hi, r31.hi)});
                        x = __builtin_amdgcn_mfma_f32_32x32x16_bf16(ka, qb, x, 0, 0, 0); __builtin_amdgcn_sched_barrier(0); }
                    if (I == J) {
#pragma unroll
                        for (int r = 0; r < 16; ++r) { const int jr = crow(r, hi); x[r] = (dir ? (jr >= r32) : (jr <= r32)) ? x[r] : 0.f; } }
                    const v4u pw0 = (v4u){pk_bf(x[0], x[1]), pk_bf(x[2], x[3]), pk_bf(x[4], x[5]), pk_bf(x[6], x[7])}, pw1 = (v4u){pk_bf(x[8], x[9]), pk_bf(x[10], x[11]), pk_bf(x[12], x[13]), pk_bf(x[14], x[15])};
#pragma unroll
                    for (int ks = 0; ks < 2; ++ks) { const bf16x8_t pa = __builtin_bit_cast(bf16x8_t, ks ? pw1 : pw0);
#pragma unroll
                        for (int eh = 0; eh < 2; ++eh) { const s16x4_t a0 = vtr16(vp + eh * 4096 + (2 * J + ks) * 1024), a1 = vtr16(vp + eh * 4096 + (2 * J + ks) * 1024 + 512);
                            const bf16x8_t vb = (bf16x8_t){a0[0], a0[1], a0[2], a0[3], a1[0], a1[1], a1[2], a1[3]};
                            if (eh) o01 = __builtin_amdgcn_mfma_f32_32x32x16_bf16(pa, vb, o01, 0, 0, 0); else o00 = __builtin_amdgcn_mfma_f32_32x32x16_bf16(pa, vb, o00, 0, 0, 0); } }
                }
                { const f32x16_t t0 = o00, t1 = o01; o00 = o10; o01 = o11; o10 = t0; o11 = t1; }
#pragma unroll
                for (int d0 = 0; d0 < 4; ++d0) { const v4u tq = qp0[d0]; qp0[d0] = qp1[d0]; qp1[d0] = tq; }
            }
            LDS_WAIT(); asm volatile("" ::: "memory");
        }
        const float og0 = p->in[10][layer * 64 + r32], og1 = p->in[10][layer * 64 + 32 + r32];
#pragma unroll 1
        for (int I = 0; I < 2; ++I) {
            const f32x16_t oa = I ? o10 : o00, ob = I ? o11 : o01;
            unsigned short gv0[16], gv1[16];
#pragma unroll
            for (int r = 0; r < 16; ++r) { const int row = row0 + 32 * I + crow(r, hi);
                const bf16* gp = (const bf16*)((const char*)P + (unsigned)(row * NP + HG_G + h * 64 + r32) * 2u); gv0[r] = gp[0]; gv1[r] = gp[32]; }
            asm volatile("" ::: "memory");
#pragma unroll
            for (int r = 0; r < 16; ++r) { const int row = row0 + 32 * I + crow(r, hi); const float t0 = oa[r], t1 = ob[r];
                float ss = t0 * t0 + t1 * t1; ss += DPP_F(ss, 0xB1); ss += DPP_F(ss, 0x4E); ss += DPP_F(ss, 0x141); ss += DPP_F(ss, 0x140);
                const float sa = rdlane(ss, 0) + rdlane(ss, 16), sb = rdlane(ss, 32) + rdlane(ss, 48);
                const float rs = __builtin_amdgcn_rsqf((hi ? sb : sa) * (1.f / 64.f) + EPS);
                const float g0 = bf2f(gv0[r]), g1 = bf2f(gv1[r]);
                bf16* mp = (bf16*)((char*)MIX + (unsigned)(row * 1024 + h * 64 + r32) * 2u);
                const unsigned pr2 = cvtpk(t0 * rs * og0 * g0 * sigm_fast(g0), t1 * rs * og1 * g1 * sigm_fast(g1));
                mp[0] = (bf16)(pr2 & 0xffffu); mp[32] = (bf16)(pr2 >> 16); }
        }
    }
}
__device__ __forceinline__ float row16_max_n(float v) { v = fmaxf(v, DPP_F(v, 0xB1)); v = fmaxf(v, DPP_F(v, 0x4E)); v = fmaxf(v, DPP_F(v, 0x141)); v = fmaxf(v, DPP_F(v, 0x140)); return v; }
__device__ __forceinline__ void ph_norm2_router_mfma(KA p, const Ctx& c, int layer, bool with_ctx) {
    const float* gain = p->in[7] + layer * 1024; const float* rw = p->in[17] + (size_t)layer * 1024 * 16;
    const bf16* X = (const bf16*)(c.ws + WS_X); bf16* H = (bf16*)(c.ws + WS_H); float* AFF = (float*)(c.ws + WS_AFF); int* SEL = (int*)(c.ws + WS_SEL);
    LAS v4u* RWH = (LAS v4u*)c.lds;
    LAS v4u* RWL = (LAS v4u*)(c.lds + 32768);
    LAS float* GS = (LAS float*)(c.lds + 65536);
    LAS float* SH = GS + 1024;
    LAS float* BIAS = SH + 1024;
    LAS float* PART = BIAS + 16;
    LAS float* RS = PART + 512 + c.wave * 16;
    int blk = blockIdx.x; asm volatile("" : "+s"(blk));
    const int tid = c.tid, lane = c.lane, r = lane & 15, q = lane >> 4;
    const int npass = c.G == 256 ? 1 : (with_ctx ? 9 : 8);
#pragma unroll 1
    for (int pass = 0; pass < npass; ++pass) {
    int bi, g0, ng, gs_ = 1;
    if (c.G == 256) {
        if (with_ctx) { if (blk < 240) { bi = blk / 30; const int jb = blk - bi * 30; ng = jb < 16 ? 9 : 8; g0 = bi * 256 + (jb < 16 ? 9 * jb : 144 + 8 * (jb - 16)); } else { bi = 8; ng = 8; g0 = 2048 + (blk - 240) * 8; } }
        else { bi = blk >> 5; ng = 8; g0 = blk * 8; } }
    else { bi = pass; const int n = bi < 8 ? 256 : 128; g0 = bi * 256 + blk; gs_ = c.G; ng = blk < n ? (n - blk + c.G - 1) / c.G : 0; }
    const float* mp = (const float*)(c.ws + WS_MOD) + ((size_t)layer * 9 + bi) * 6144;
    for (int i = tid; i < 1024; i += 512) { GS[i] = gain[i] * (1.f + mp[4096 + i]); SH[i] = mp[3072 + i]; }
    __syncthreads();
#pragma unroll 1
    for (int it = 0; it < 4; ++it) { const int wd = tid + 512 * it, k0 = (wd >> 4) * 8, e = wd & 15; unsigned hi[8], lo[8];
#pragma unroll
        for (int j = 0; j < 8; ++j) { const float w = GS[k0 + j] * rw[(k0 + j) * 16 + e]; hi[j] = f2bf(w); lo[j] = f2bf(w - bf2f(hi[j])); }
        RWH[wd] = (v4u){hi[0] | (hi[1] << 16), hi[2] | (hi[3] << 16), hi[4] | (hi[5] << 16), hi[6] | (hi[7] << 16)};
        RWL[wd] = (v4u){lo[0] | (lo[1] << 16), lo[2] | (lo[3] << 16), lo[4] | (lo[5] << 16), lo[6] | (lo[7] << 16)}; }
    { const int e = tid & 15, part = tid >> 4; float a = 0.f;
#pragma unroll 8
      for (int k = 32 * part; k < 32 * part + 32; ++k) a += SH[k] * rw[k * 16 + e];
      PART[part * 16 + e] = a; }
    __syncthreads();
    if (tid < 16) { float a = 0.f;
#pragma unroll
        for (int pt = 0; pt < 32; ++pt) a += PART[pt * 16 + tid];
        BIAS[tid] = a; }
    __syncthreads();
#pragma unroll 1
    for (int gi = c.wave; gi < ng; gi += 8) {
        asm volatile("" ::: "memory");
        const int row0 = (g0 + gi * gs_) * 16;
        const bf16* xp = X + (size_t)(row0 + r) * 1024 + 8 * q;
        v4u xa[32];
#pragma unroll
        for (int s = 0; s < 32; ++s) xa[s] = *(const v4u*)(xp + 32 * s);
        pg8::f32x4 ah = {0.f, 0.f, 0.f, 0.f}, al = ah, as = ah;
#pragma unroll
        for (int s = 0; s < 32; ++s) { const pg8::bf16x8 a = __builtin_bit_cast(pg8::bf16x8, xa[s]);
            const pg8::bf16x8 bh = __builtin_bit_cast(pg8::bf16x8, RWH[s * 64 + lane]), bl = __builtin_bit_cast(pg8::bf16x8, RWL[s * 64 + lane]);
            ah = __builtin_amdgcn_mfma_f32_16x16x32_bf16(a, bh, ah, 0, 0, 0); al = __builtin_amdgcn_mfma_f32_16x16x32_bf16(a, bl, al, 0, 0, 0); as = __builtin_amdgcn_mfma_f32_16x16x32_bf16(a, a, as, 0, 0, 0);
            if ((s & 7) == 7) asm volatile("" ::: "memory"); }
        if ((r >> 2) == q) { const int i = r & 3; const float ssv = i == 0 ? as[0] : i == 1 ? as[1] : i == 2 ? as[2] : as[3]; RS[r] = rsqrtf(ssv * (1.f / 1024.f) + EPS); }
        LDS_WAIT(); asm volatile("" ::: "memory");
        const float rs_r = RS[r]; const pg8::f32x4 rs4 = *(const LAS pg8::f32x4*)(RS + 4 * q); const float bias = BIAS[r];
#pragma unroll
        for (int i = 0; i < 4; ++i) { const float lg = rs4[i] * (ah[i] + al[i]) + bias;
            const float mx = row16_max_n(lg), pe = expf(lg - mx), sm = row16_sum_n(pe);
            AFF[(size_t)(row0 + 4 * q + i) * 16 + r] = pe * (1.f / sm); SEL[(size_t)(row0 + 4 * q + i) * 16 + r] = -1; }
        bf16* hp = H + (size_t)(row0 + r) * 1024 + 8 * q;
#pragma unroll
        for (int s = 0; s < 32; ++s) { float xv[8]; unpack8(xa[s], xv);
            const pg8::f32x4 g0v = *(const LAS pg8::f32x4*)(GS + 32 * s + 8 * q), g1v = *(const LAS pg8::f32x4*)(GS + 32 * s + 8 * q + 4), s0v = *(const LAS pg8::f32x4*)(SH + 32 * s + 8 * q), s1v = *(const LAS pg8::f32x4*)(SH + 32 * s + 8 * q + 4);
            *(v4u*)(hp + 32 * s) = (v4u){cvtpk(xv[0] * rs_r * g0v.x + s0v.x, xv[1] * rs_r * g0v.y + s0v.y), cvtpk(xv[2] * rs_r * g0v.z + s0v.z, xv[3] * rs_r * g0v.w + s0v.w),
                                         cvtpk(xv[4] * rs_r * g1v.x + s1v.x, xv[5] * rs_r * g1v.y + s1v.y), cvtpk(xv[6] * rs_r * g1v.z + s1v.z, xv[7] * rs_r * g1v.w + s1v.w)};
            if ((s & 3) == 3) asm volatile("" ::: "memory"); }
        LDS_WAIT(); asm volatile("" ::: "memory");
    }
    __syncthreads();
    }
}

__device__ __forceinline__ void ph_mla_prep16(KA p, const Ctx& c, int layer) {
    if (c.wave < HG1_WAVES) return;
    const int pw = c.wave - HG1_WAVES, lane = c.lane, r = lane & 15, q = lane >> 4;
    const bf16* P = (const bf16*)(c.ws + WS_P); bf16* AM = (bf16*)(c.ws + WS_AM); bf16* KM = (bf16*)(c.ws + WS_KM); const float* RT = (const float*)(c.ws + WS_ROPE);
    const float* gq = p->in[11] + layer * 256 + 8 * q; const float* gkv = p->in[13] + layer * 128 + 8 * q;
    LAS float* RS = (LAS float*)(c.lds + HG1_WAVES * HG_WAVE_BYTES) + pw * 32;
    f32x4 gqa[8][2], gka[4][2];
#pragma unroll
    for (int s = 0; s < 8; ++s) { gqa[s][0] = *(const f32x4*)(gq + 32 * s); gqa[s][1] = *(const f32x4*)(gq + 32 * s + 4); }
#pragma unroll
    for (int s = 0; s < 4; ++s) { gka[s][0] = *(const f32x4*)(gkv + 32 * s); gka[s][1] = *(const f32x4*)(gkv + 32 * s + 4); }
    const int half = q >> 1, p0 = 4 * (q & 1);
#pragma unroll 1
    for (int g = (int)blockIdx.x * (8 - HG1_WAVES) + pw; g < MALL / 16; g += c.G * (8 - HG1_WAVES)) {
        asm volatile("" ::: "memory");
        const int row = 16 * g + r; const bf16* pr = P + (size_t)row * NP;
        v4u xa[8], xk[4];
#pragma unroll
        for (int s = 0; s < 8; ++s) xa[s] = *(const v4u*)(pr + ML_CQ + 32 * s + 8 * q);
#pragma unroll
        for (int s = 0; s < 4; ++s) xk[s] = *(const v4u*)(pr + ML_CKV + 32 * s + 8 * q);
        const v2u x1w = *(const v2u*)(pr + ML_KR + 16 * half + p0), x2w = *(const v2u*)(pr + ML_KR + 16 * half + 8 + p0);
        const int tk = row & 4095, pos = half ? (tk & 63) : (tk >> 6);
        const f32x4 cs01 = *(const f32x4*)(RT + (pos * 8 + p0) * 2), cs23 = *(const f32x4*)(RT + (pos * 8 + p0) * 2 + 4);
        pg8::f32x4 aq = {0.f, 0.f, 0.f, 0.f}, ak = aq;
#pragma unroll
        for (int s = 0; s < 8; ++s) { const pg8::bf16x8 a = __builtin_bit_cast(pg8::bf16x8, xa[s]); aq = __builtin_amdgcn_mfma_f32_16x16x32_bf16(a, a, aq, 0, 0, 0); }
#pragma unroll
        for (int s = 0; s < 4; ++s) { const pg8::bf16x8 a = __builtin_bit_cast(pg8::bf16x8, xk[s]); ak = __builtin_amdgcn_mfma_f32_16x16x32_bf16(a, a, ak, 0, 0, 0); }
        if ((r >> 2) == q) { const int i = r & 3; const float sq = i == 0 ? aq[0] : i == 1 ? aq[1] : i == 2 ? aq[2] : aq[3], sk = i == 0 ? ak[0] : i == 1 ? ak[1] : i == 2 ? ak[2] : ak[3];
            RS[r] = rsqrtf(sq * (1.f / 256.f) + EPS); RS[16 + r] = rsqrtf(sk * (1.f / 128.f) + EPS); }
        LDS_WAIT(); asm volatile("" ::: "memory");
        const float rq = RS[r], rk = RS[16 + r];
        bf16* am = AM + (size_t)row * 384 + 8 * q;
#pragma unroll
        for (int s = 0; s < 8; ++s) { float xv[8]; unpack8(xa[s], xv);
            *(v4u*)(am + 32 * s) = (v4u){cvtpk(xv[0] * rq * gqa[s][0].x, xv[1] * rq * gqa[s][0].y), cvtpk(xv[2] * rq * gqa[s][0].z, xv[3] * rq * gqa[s][0].w),
                                         cvtpk(xv[4] * rq * gqa[s][1].x, xv[5] * rq * gqa[s][1].y), cvtpk(xv[6] * rq * gqa[s][1].z, xv[7] * rq * gqa[s][1].w)}; }
#pragma unroll
        for (int s = 0; s < 4; ++s) { float xv[8]; unpack8(xk[s], xv);
            *(v4u*)(am + 256 + 32 * s) = (v4u){cvtpk(xv[0] * rk * gka[s][0].x, xv[1] * rk * gka[s][0].y), cvtpk(xv[2] * rk * gka[s][0].z, xv[3] * rk * gka[s][0].w),
                                               cvtpk(xv[4] * rk * gka[s][1].x, xv[5] * rk * gka[s][1].y), cvtpk(xv[6] * rk * gka[s][1].z, xv[7] * rk * gka[s][1].w)}; }
        const float a0 = bf2f(x1w.x & 0xffffu), a1 = bf2f(x1w.x >> 16), a2 = bf2f(x1w.y & 0xffffu), a3 = bf2f(x1w.y >> 16);
        const float b0 = bf2f(x2w.x & 0xffffu), b1 = bf2f(x2w.x >> 16), b2 = bf2f(x2w.y & 0xffffu), b3 = bf2f(x2w.y >> 16);
        v4u kw; int b, kvi;
        if (row < MLAT) { b = row >> 12; kvi = row & 4095;
            kw = (v4u){cvtpk(a0 * cs01.x - b0 * cs01.y, a1 * cs01.z - b1 * cs01.w), cvtpk(a2 * cs23.x - b2 * cs23.y, a3 * cs23.z - b3 * cs23.w),
                       cvtpk(b0 * cs01.x + a0 * cs01.y, b1 * cs01.z + a1 * cs01.w), cvtpk(b2 * cs23.x + a2 * cs23.y, b3 * cs23.z + a3 * cs23.w)}; }
        else { const int rr = row - MLAT; b = rr >> 8; kvi = T + (rr & 255); kw = (v4u){x1w.x, x1w.y, x2w.x, x2w.y}; }
        const int tile = kvi >> 6, kvr = kvi & 63;
#pragma unroll
        for (int h = 0; h < 6; ++h) *(v4u*)(KM + ((size_t)((b * 6 + h) * NKT + tile) * 12 + 8 + q) * 512 + kvr * 8) = kw;
        LDS_WAIT(); asm volatile("" ::: "memory");
    }
}
typedef pg8::f32x4 A4;
struct EpiP {
    static constexpr bool PERM = true, AFTER_DRAIN = false;
    bf16* O; int ldc;
    __device__ __forceinline__ void operator()(const A4 (&acc)[2][2][4][2], const pg8::Unit& u, int wr, int wc, int fr, int fq) const {
        const int row0 = u.pm * 256 + wr * 64 + fr, col0 = u.pn * 256 + wc * 32 + 8 * fq;
#pragma unroll
        for (int ai = 0; ai < 2; ++ai)
#pragma unroll
            for (int m = 0; m < 4; ++m) { bf16* rp = O + (size_t)(row0 + ai * 128 + m * 16) * ldc + col0;
#pragma unroll
                for (int bj = 0; bj < 2; ++bj) { const A4 v0 = acc[ai][bj][m][0], v1 = acc[ai][bj][m][1];
                    *(v4u*)(rp + bj * 128) = (v4u){pg8::cvt_pk_bf16(v0[0], v0[1]), pg8::cvt_pk_bf16(v0[2], v0[3]), pg8::cvt_pk_bf16(v1[0], v1[1]), pg8::cvt_pk_bf16(v1[2], v1[3])}; } }
    }
};
struct EpiMla {
    static constexpr bool PERM = true, AFTER_DRAIN = false;
    unsigned char* ws;
    __device__ __forceinline__ void operator()(const A4 (&acc)[2][2][4][2], const pg8::Unit& u, int wr, int wc, int fr, int fq) const {
        const int part = u.pn >= 3 ? 1 : 0, hp = u.pn - part * 3;
        if (part == 0 && wc == 3) return;
        bf16* QM = (bf16*)(ws + WS_QM); bf16* KM = (bf16*)(ws + WS_KM); bf16* VM = (bf16*)(ws + WS_VM); const float* RT = (const float*)(ws + WS_ROPE);
#pragma unroll
        for (int ai = 0; ai < 2; ++ai) {
            A4 rc[4][2];
            if (part == 0 && wc == 2) {
#pragma unroll
                for (int m = 0; m < 4; ++m) { const int row = u.pm * 256 + ai * 128 + wr * 64 + m * 16 + fr, t = row & 4095, half = fq >> 1, pos = half ? (t & 63) : (t >> 6);
                    const float* rt = RT + (pos * 8 + 4 * (fq & 1)) * 2; rc[m][0] = *(const A4*)rt; rc[m][1] = *(const A4*)(rt + 4); } }
#pragma unroll
            for (int m = 0; m < 4; ++m) {
                asm volatile("" ::: "memory");
                const int row = u.pm * 256 + ai * 128 + wr * 64 + m * 16 + fr;
                int b, qi, t; bool isctx;
                if (row < MLAT) { b = row >> 12; t = row & 4095; qi = t; isctx = false; } else { const int rr = row - MLAT; b = rr >> 8; t = 0; qi = T + (rr & 255); isctx = true; }
                const int tile = qi >> 6, kvr = qi & 63;
#pragma unroll
                for (int bj = 0; bj < 2; ++bj) { const int bh = b * 6 + 2 * hp + bj; A4 v0 = acc[ai][bj][m][0], v1 = acc[ai][bj][m][1];
                    if (part == 0) {
                        if (wc == 2 && !isctx) {
                            const A4 c01 = rc[m][0], c23 = rc[m][1];
                            const A4 x1 = v0, x2 = v1;
                            v0 = (A4){x1[0] * c01[0] - x2[0] * c01[1], x1[1] * c01[2] - x2[1] * c01[3], x1[2] * c23[0] - x2[2] * c23[1], x1[3] * c23[2] - x2[3] * c23[3]};
                            v1 = (A4){x2[0] * c01[0] + x1[0] * c01[1], x2[1] * c01[2] + x1[1] * c01[3], x2[2] * c23[0] + x1[2] * c23[1], x2[3] * c23[2] + x1[3] * c23[3]}; }
                        v0 = v0 * MLA_QS; v1 = v1 * MLA_QS;
                        *(v4u*)(QM + ((size_t)bh * NQK + qi) * 96 + wc * 32 + 8 * fq) = (v4u){pg8::cvt_pk_bf16(v0[0], v0[1]), pg8::cvt_pk_bf16(v0[2], v0[3]), pg8::cvt_pk_bf16(v1[0], v1[1]), pg8::cvt_pk_bf16(v1[2], v1[3])};
                    } else {
                        const v4u w = (v4u){pg8::cvt_pk_bf16(v0[0], v0[1]), pg8::cvt_pk_bf16(v0[2], v0[3]), pg8::cvt_pk_bf16(v1[0], v1[1]), pg8::cvt_pk_bf16(v1[2], v1[3])};
                        if (wc < 2) *(v4u*)(KM + ((size_t)(bh * NKT + tile) * 12 + 4 * wc + fq) * 512 + kvr * 8) = w;
                        else *(v4u*)(VM + ((size_t)(bh * NKT + tile) * 2 + (wc - 2)) * 2048 + kvr * 32 + fq * 8) = w;
                    } }
            }
        }
    }
};
struct EpiOut {
    static constexpr bool PERM = true, AFTER_DRAIN = false;
    bf16* X; const float* xlat; const float* xctx; const float* MODl; float scale; int src_f32;
    __device__ __forceinline__ void operator()(const A4 (&acc)[2][2][4][2], const pg8::Unit& u, int wr, int wc, int fr, int fq) const {
        const int row0 = u.pm * 256 + wr * 64 + fr, col0 = u.pn * 256 + wc * 32 + 8 * fq;
        const int bi = (u.pm < MLAT / 256) ? (u.pm >> 4) : 8; const float* ga = MODl + bi * 6144 + 2048;
#pragma unroll
        for (int aim = 0; aim < 4; ++aim) { const int ai = aim >> 1, m0 = (aim & 1) * 2;
            v4u wb[4][2]; A4 xf[4][2][2];
#pragma unroll
            for (int m = m0; m < m0 + 2; ++m) { const int row = row0 + ai * 128 + m * 16;
                const float* src = row < MLAT ? xlat + (size_t)row * 1024 : xctx + (size_t)(row - MLAT) * 1024; const bf16* dstc = X + (size_t)row * 1024;
#pragma unroll
                for (int bj = 0; bj < 2; ++bj) { const int col = col0 + bj * 128;
                    if (src_f32) { xf[m][bj][0] = *(const A4*)(src + col); xf[m][bj][1] = *(const A4*)(src + col + 4); } else wb[m][bj] = *(const v4u*)(dstc + col); } }
            asm volatile("" ::: "memory");
#pragma unroll
            for (int m = m0; m < m0 + 2; ++m) { const int row = row0 + ai * 128 + m * 16; bf16* dst = X + (size_t)row * 1024;
#pragma unroll
                for (int bj = 0; bj < 2; ++bj) { const int col = col0 + bj * 128; A4 x0, x1;
                    if (src_f32) { x0 = xf[m][bj][0]; x1 = xf[m][bj][1]; }
                    else { const v4u w = wb[m][bj]; x0 = (A4){bf2f(w.x & 0xffffu), bf2f(w.x >> 16), bf2f(w.y & 0xffffu), bf2f(w.y >> 16)}; x1 = (A4){bf2f(w.z & 0xffffu), bf2f(w.z >> 16), bf2f(w.w & 0xffffu), bf2f(w.w >> 16)}; }
                    const A4 v0 = x0 + *(const A4*)(ga + col) * scale * acc[ai][bj][m][0], v1 = x1 + *(const A4*)(ga + col + 4) * scale * acc[ai][bj][m][1];
                    *(v4u*)(dst + col) = (v4u){pg8::cvt_pk_bf16(v0[0], v0[1]), pg8::cvt_pk_bf16(v0[2], v0[3]), pg8::cvt_pk_bf16(v1[0], v1[1]), pg8::cvt_pk_bf16(v1[2], v1[3])}; } }
            asm volatile("" ::: "memory"); }
    }
};
struct EpiAct {
    static constexpr bool PERM = true, AFTER_DRAIN = false;
    bf16* ACT;
    __device__ __forceinline__ void operator()(const A4 (&acc)[2][2][4][2], const pg8::Unit& u, int wr, int wc, int fr, int fq) const {
        const int row0 = u.pm * 256 + wr * 64 + fr, col0 = (u.pn & 7) * 128 + wc * 32 + 8 * fq;
#pragma unroll
        for (int ai = 0; ai < 2; ++ai)
#pragma unroll
            for (int m = 0; m < 4; ++m) { float r[8];
#pragma unroll
                for (int n = 0; n < 2; ++n)
#pragma unroll
                    for (int i = 0; i < 4; ++i) { const float a = acc[ai][0][m][n][i], g = acc[ai][1][m][n][i]; r[n * 4 + i] = a * g * __builtin_amdgcn_rcpf(1.f + __builtin_amdgcn_exp2f(-a * LOG2E)); }
                *(v4u*)(ACT + (size_t)(row0 + ai * 128 + m * 16) * 1024 + col0) = (v4u){pg8::cvt_pk_bf16(r[0], r[1]), pg8::cvt_pk_bf16(r[2], r[3]), pg8::cvt_pk_bf16(r[4], r[5]), pg8::cvt_pk_bf16(r[6], r[7])}; }
    }
};
struct EpiY {
    static constexpr bool PERM = true, AFTER_DRAIN = false;
    bf16* Y;
    __device__ __forceinline__ void operator()(const A4 (&acc)[2][2][4][2], const pg8::Unit& u, int wr, int wc, int fr, int fq) const {
        const int row0 = u.pm * 256 + wr * 64 + fr, col0 = (u.pn & 3) * 256 + wc * 32 + 8 * fq;
#pragma unroll
        for (int ai = 0; ai < 2; ++ai)
#pragma unroll
            for (int m = 0; m < 4; ++m) { bf16* rp = Y + (size_t)(row0 + ai * 128 + m * 16) * 1024 + col0;
#pragma unroll
                for (int bj = 0; bj < 2; ++bj) { const A4 v0 = acc[ai][bj][m][0], v1 = acc[ai][bj][m][1];
                    *(v4u*)(rp + bj * 128) = (v4u){pg8::cvt_pk_bf16(v0[0], v0[1]), pg8::cvt_pk_bf16(v0[2], v0[3]), pg8::cvt_pk_bf16(v1[0], v1[1]), pg8::cvt_pk_bf16(v1[2], v1[3])}; } }
    }
};
struct SchedE1 {
    int G, c, nunits;
    __device__ __forceinline__ bool next(int i, pg8::Unit& u) const { const int L = i * G + c; if (L >= nunits) return false; u.kt0 = 0; u.ntu = 0;
        if (L < 2048) { const int rnd = L >> 8, x = L & 7, j = (L >> 3) & 31, e = 2 * rnd + (x >> 2), mt = (x & 3) * 4 + (j & 3), pnl = j >> 2;
            u.pm = ((mt >> 1) * 16 + e) * 2 + (mt & 1); u.pn = e * 8 + pnl; }
        else { const int r = L - 2048, e = r >> 3; u.pm = 256 + e; u.pn = e * 8 + (r & 7); }
        return true; }
    __device__ __forceinline__ void a_ready(const pg8::Unit&) const {}
    __device__ __forceinline__ void done(const pg8::Unit&) const {}
};
struct SchedE2 {
    int G, c, nunits;
    __device__ __forceinline__ bool next(int i, pg8::Unit& u) const { const int L = i * G + c; if (L >= nunits) return false; u.kt0 = 0; u.ntu = 0;
        if (L < 1024) { const int rnd = L >> 8, x = L & 7, j = (L >> 3) & 31, e = 4 * rnd + (x >> 1), mt = (x & 1) * 8 + (j & 7), pnl = j >> 3;
            u.pm = ((mt >> 1) * 16 + e) * 2 + (mt & 1); u.pn = e * 4 + pnl; }
        else { const int r = L - 1024, e = r >> 2; u.pm = 256 + e; u.pn = e * 4 + (r & 3); }
        return true; }
    __device__ __forceinline__ void a_ready(const pg8::Unit&) const {}
    __device__ __forceinline__ void done(const pg8::Unit&) const {}
};
#ifndef MK_SIMPLE_ATTN
#define MK_SIMPLE_ATTN 0
#endif
#ifndef MK_HGRN_MFMA
#define MK_HGRN_MFMA 1
#endif
#ifndef MK_MLA_V2
#define MK_MLA_V2 1
#endif
#ifndef MK_REP
#define MK_REP 0
#endif
#define REP(id) for (int rep_ = 0; rep_ < ((MK_REP == (id)) ? 2 : 1); ++rep_)
#ifndef MK_PHMASK
#define MK_PHMASK 0xfff
#endif
#define PHEN(i) ((MK_PHMASK >> (i)) & 1)
constexpr int CW_BAR = 1024;

__global__ void __launch_bounds__(512, 2) mk_fwd(KP pv) {
    extern __shared__ __attribute__((aligned(16))) unsigned char lds_raw[];
    Ctx c; c.lds = (LAS unsigned char*)lds_raw; c.ws = pv.ws; c.wave = __builtin_amdgcn_readfirstlane((int)threadIdx.x >> 6); c.lane = lane_id_asm(); c.tid = c.wave * 64 + c.lane;
    c.G = gridDim.x; c.gw = blockIdx.x * 8 + c.wave; c.NGW = c.G * 8;
    volatile LAS unsigned* MISC = (volatile LAS unsigned*)(c.lds + MISC_OFF);
    if (c.tid < 64) MISC[c.tid] = 0u;
    __syncthreads();
    const int li_s = pv.li; (void)xcd_barrier_post((unsigned*)(pv.ws + WS_CTL) + CW_BAR + pv.li * XCD_BAR_WORDS, MISC + 8);
    const int ph_lo = pv.ph_lo, ph_hi = pv.ph_hi; KA p;
    int gp = 0;
#define RUN(k) (ph_lo <= (k) && (k) < ph_hi)
#ifndef MK_BARX
#define MK_BARX 1
#endif
#define SEAM(k) do { if (RUN(k) && RUN((k) + 1)) { for (int bx_ = 0; bx_ < MK_BARX; ++bx_) { const int l_ = lane_id_asm(); XcdBarrier b_; b_.bar = (unsigned*)(c0.ws + WS_CTL) + CW_BAR + li_s * XCD_BAR_WORDS; b_.x = xb_xcc_id(); b_.st = MISC + 8; xcd_barrier(b_, c0.wave == 0 && l_ == 0); } } } while (0)
    LAS unsigned char* ring = c.lds;
    const Ctx c0 = c;
#define FRESH() do { c = c0; p = (KA)__builtin_amdgcn_kernarg_segment_ptr(); c.lane = lane_id_asm(); asm volatile("" : "+s"(c.wave), "+s"(c.gw), "+s"(p)); c.tid = c.wave * 64 + c.lane; c.ws = p->ws; } while (0)

    if (PHEN(0) && RUN(gp)) { FRESH(); REP(16) { ph_prologue(p, c); __syncthreads(); } }
    SEAM(gp); ++gp;

#pragma unroll 1
    for (int layer = 0; layer < DEPTH; ++layer) {
        const bool with_ctx = layer < DEPTH - 1;
#define XLAT (p->in[0])
#define XCTX (p->in[2])
#define MODL ((const float*)(c.ws + WS_MOD) + (size_t)layer * 9 * 6144)
        if (PHEN(1) && RUN(gp)) { FRESH(); REP(1) { ph_convert(p, c, layer); __syncthreads(); } if (MK_REP == 18 && layer > 0) ph_norm<false, true, true>(p, c, layer, XLAT, XCTX, MALL); REP(2) { if (layer == 0) ph_norm4<false, false>(p, c, layer, XLAT, XCTX, MALL); else ph_norm<false, true>(p, c, layer, XLAT, XCTX, MALL); } }
        SEAM(gp); ++gp;
        if (PHEN(2) && RUN(gp)) { FRESH(); pg8::Gemm g{(const bf16*)(c.ws + WS_H), (const bf16*)(c.ws + WS_WIN), MALL, NP, 1024}; pg8::StaticOrder S; S.init(MALL, NP, c.G, (int)blockIdx.x);
            EpiP E{(bf16*)(c.ws + WS_P), NP}; REP(10) pg8::gemm_phase<EpiP, pg8::StaticOrder, true, true, 1024>(ring, g, S, E, c.wave); }
        SEAM(gp); ++gp;
        if (PHEN(3) && RUN(gp)) { FRESH(); REP(3) { if (MK_HGRN_MFMA) ph_hgrn1_mfma(p, c, layer); else ph_hgrn_pass1(p, c, layer); } FRESH(); REP(4) ph_mla_prep16(p, c, layer); }
        SEAM(gp); ++gp;
        if (PHEN(4) && RUN(gp)) { FRESH(); if (MK_HGRN_MFMA) ph_hgrn_scan_t(c); else ph_hgrn_scan(c);
            pg8::Gemm g{(const bf16*)(c.ws + WS_AM), (const bf16*)(c.ws + WS_WMLA), MALL, 1536, 384}; pg8::StaticOrder S; S.init(MALL, 1536, c.G, (int)blockIdx.x); S.bdiag = 1;
            EpiMla E{c.ws};
            __syncthreads(); REP(11) pg8::gemm_phase<EpiMla, pg8::StaticOrder, true, true, 384>(ring, g, S, E, c.wave); }
        SEAM(gp); ++gp;
        if (PHEN(5) && RUN(gp)) { FRESH(); REP(5) { if (MK_HGRN_MFMA) ph_hgrn3_mfma(p, c, layer, with_ctx); else ph_hgrn_pass3(p, c, layer, with_ctx); } if (MK_SIMPLE_ATTN & 1) ph_attn_mla_simple(c, with_ctx); else REP(6) { __syncthreads(); FRESH(); if (MK_MLA_V2) ph_attn_mla2(c, with_ctx); else ph_attn_mla(c, with_ctx); } if (MK_SIMPLE_ATTN & 2) ph_attn_na_simple(p, c, layer, with_ctx); else REP(7) { __syncthreads(); FRESH(); ph_attn_na(p, c, layer, with_ctx); } }
        SEAM(gp); ++gp;
        if (PHEN(6) && RUN(gp)) { FRESH(); const int M = with_ctx ? MALL : MLAT; pg8::Gemm g{(const bf16*)(c.ws + WS_MIX), (const bf16*)(c.ws + WS_WOUT), M, 1024, 1024}; pg8::StaticOrder S; S.init(M, 1024, c.G, (int)blockIdx.x);
            REP(15) { EpiOut E{(bf16*)(c.ws + WS_X), XLAT, XCTX, MODL, rep_ ? 0.f : 1.f, (layer == 0 && !rep_) ? 1 : 0}; pg8::gemm_phase<EpiOut, pg8::StaticOrder, true, true, 1024>(ring, g, S, E, c.wave); } }
        SEAM(gp); ++gp;
        if (PHEN(7) && RUN(gp)) { FRESH(); REP(9) ph_norm2_router_mfma(p, c, layer, with_ctx); }
        SEAM(gp); ++gp;
        if (PHEN(8) && RUN(gp)) { FRESH(); REP(8) { __syncthreads(); ph_topk(c, with_ctx); } }
        SEAM(gp); ++gp;
        if (PHEN(9) && RUN(gp)) { FRESH(); pg8::Gemm g{(const bf16*)(c.ws + WS_H), (const bf16*)(c.ws + WS_W13), XS_ROWS, 2048 * NE, 1024};     SchedE1 S{c.G, (int)blockIdx.x, with_ctx ? 2176 : 2048};
            EpiAct E{(bf16*)(c.ws + WS_ACT)}; __syncthreads(); REP(13) pg8::gemm_phase<EpiAct, SchedE1, true, true, 1024, true>(ring, g, S, E, c.wave, (const int*)(c.ws + WS_IDX)); }
        SEAM(gp); ++gp;
        if (PHEN(10) && RUN(gp)) { FRESH(); pg8::Gemm g{(const bf16*)(c.ws + WS_ACT), (const bf16*)(c.ws + WS_W2), XS_ROWS, 1024 * NE, 1024}; SchedE2 S{c.G, (int)blockIdx.x, with_ctx ? 1088 : 1024};
            EpiY E{(bf16*)(c.ws + WS_Y)}; REP(14) pg8::gemm_phase<EpiY, SchedE2, true, true, 1024>(ring, g, S, E, c.wave); }
        SEAM(gp); ++gp;
    }
    if (PHEN(11) && RUN(gp)) { FRESH(); REP(17) ph_final(p, c); }
#undef RUN
#undef SEAM
}

#ifndef MK_N_LAUNCHES
#define MK_N_LAUNCHES 1
#endif
extern "C" void kernel_launch(void* const* d_in, const int* in_sizes, int n_in, void* d_out, int out_size, void* d_ws, size_t ws_size, hipStream_t stream) {
    static int grid = 0;
    if (grid == 0) {
        if (n_in != 22 || ws_size < WS_END) { fprintf(stderr, "kernel_launch: expected 22 inputs and >= %zu bytes of workspace; got %d, %zu\n", (size_t)WS_END, n_in, ws_size); grid = -1; return; }
        int dev = 0, cus = 0, per_cu = 0;
        if (hipGetDevice(&dev) != hipSuccess || hipDeviceGetAttribute(&cus, hipDeviceAttributeMultiprocessorCount, dev) != hipSuccess) { grid = -1; return; }
        if (hipFuncSetAttribute((const void*)mk_fwd, hipFuncAttributeMaxDynamicSharedMemorySize, LDS_BYTES) != hipSuccess) { fprintf(stderr, "kernel_launch: hipFuncSetAttribute failed\n"); grid = -1; return; }
        if (hipOccupancyMaxActiveBlocksPerMultiprocessor(&per_cu, (const void*)mk_fwd, 512, LDS_BYTES) != hipSuccess || per_cu < 1) { fprintf(stderr, "kernel_launch: occupancy query reports %d\n", per_cu); }
        (void)hipGetLastError();
        grid = cus;
        if (grid > 256) grid = 256;
    }
    if (grid < 0) return;
    (void)in_sizes; (void)out_size;
    if (hipMemsetAsync((char*)d_ws + WS_CTL, 0, CTL_BYTES, stream) != hipSuccess) return;
    KP a{};
    for (int i = 0; i < 22; ++i) a.in[i] = (const float*)d_in[i];
    a.out = (float*)d_out; a.ws = (unsigned char*)d_ws; a.pad = 0;
    if (MK_N_LAUNCHES == 1) { a.ph_lo = 0; a.ph_hi = NPHASES; a.li = 0; hipLaunchKernelGGL(mk_fwd, dim3(grid), dim3(512), LDS_BYTES, stream, a); }
    else { for (int k = 0; k < NPHASES; ++k) { a.ph_lo = k; a.ph_hi = k + 1; a.li = k; hipLaunchKernelGGL(mk_fwd, dim3(grid), dim3(512), LDS_BYTES, stream, a); } }
}
```

```cpp
#include <hip/hip_runtime.h>
#include <cstdio>
#include <cstdint>
namespace pg8 {
#define PG8_LAS __attribute__((address_space(3)))
typedef unsigned short bf16_t;
typedef short bf16x8 __attribute__((ext_vector_type(8)));
typedef float f32x4 __attribute__((ext_vector_type(4)));
typedef unsigned u32x4 __attribute__((ext_vector_type(4)));
constexpr int BM = 256, BK = 64, HALF = 128, HTB = HALF * BK * 2  , STAGE_BYTES = 8 * HTB, NXCD = 8, WGM = 8;

__host__ __device__ __forceinline__ int lds_byte(int r, int c) { const int st = (r >> 4) * 2 + (c >> 5), rr = r & 15, cc = c & 31, ob = rr * 64 + cc * 2; return st * 1024 + (ob ^ (((ob >> 9) & 1) << 5)); }
__host__ __device__ __forceinline__ void stage_rc(int b, int& R, int& C) { const int st = b / 1024, sb = b % 1024, swz = sb ^ (((sb >> 9) & 1) << 5); R = (st >> 1) * 16 + swz / 64; C = (st & 1) * 32 + (swz % 64) / 2; }
__host__ __device__ __forceinline__ int perm32(int rho) { const int n = rho >> 4, i = rho & 15; return 8 * (i >> 2) + 4 * n + (i & 3); }

struct Unit { int pm, pn, kt0 = 0, ntu = 0; };
struct Gemm { const bf16_t* A; const bf16_t* Bt; int M, N, K; };

struct StaticOrder {
    int nM, nN, nwg, G, c, bdiag = 0;
    __host__ __device__ void init(int M, int N, int G_, int c_) { nM = M / BM; nN = N / BM; nwg = nM * nN; G = G_; c = c_; }
    __host__ __device__ bool next(int i, Unit& u) const {
        const long L = (long)i * G + c; if (L >= nwg) return false;
        int wgid = (int)L; { const int q = nwg / NXCD, r = nwg % NXCD, xcd = wgid % NXCD, off = wgid / NXCD; wgid = (xcd < r ? xcd * (q + 1) : r * (q + 1) + (xcd - r) * q) + off; }
        const int nig = WGM * nN, gid = wgid / nig, fm = gid * WGM, gsz = (nM - fm) < WGM ? (nM - fm) : WGM;
        u.pm = fm + ((wgid % nig) % gsz); u.pn = (wgid % nig) / gsz; u.kt0 = 0; u.ntu = 0; if (bdiag) { if (u.pn < 3) u.ntu = 4; else { u.kt0 = 4; u.ntu = 2; } } return true;
    }
    __device__ __forceinline__ void a_ready(const Unit&) const {}
    __device__ __forceinline__ void done(const Unit&) const {}
};
__device__ __forceinline__ unsigned cvt_pk_bf16(float lo, float hi) { unsigned r; asm volatile("v_cvt_pk_bf16_f32 %0, %1, %2" : "=v"(r) : "v"(lo), "v"(hi)); return r; }
typedef float f32x2 __attribute__((ext_vector_type(2)));
template <class Epi, class Sched, bool ALIGN_EPI = false, bool SP2 = false, int KC = 0, bool GATHER = false>
__device__ __forceinline__ void gemm_phase(PG8_LAS unsigned char* lds, const Gemm g, const Sched& S, const Epi& E, int wave_id, const int* gidx = nullptr) {
    int tid_l; asm volatile("v_mbcnt_lo_u32_b32 %0, -1, 0\n\tv_mbcnt_hi_u32_b32 %0, -1, %0" : "=v"(tid_l)); tid_l += wave_id * 64;
    const int tid = tid_l, wid = __builtin_amdgcn_readfirstlane(tid >> 6), lane = tid & 63, wr = wid >> 2, wc = wid & 3, fr = lane & 15, fq = lane >> 4;
    const int K = KC ? KC : g.K, nt = K / BK;
    unsigned voffA[2], voffB[2];
#pragma unroll
    for (int i = 0; i < 2; ++i) { int R, C; stage_rc(tid * 16 + i * 8192, R, C); const int Rb = Epi::PERM ? ((R & ~31) + perm32(R & 31)) : R;
        voffA[i] = (unsigned)(R * K + C) * 2u; voffB[i] = (unsigned)(Rb * K + C) * 2u; }
    unsigned rcA[2], gC[2][2], gN[2][2];
#pragma unroll
    for (int i = 0; i < 2; ++i) { int R, C; stage_rc(tid * 16 + i * 8192, R, C); rcA[i] = (unsigned)R | ((unsigned)(C * 2) << 16); gC[0][i] = gC[1][i] = gN[0][i] = gN[1][i] = 0u; }
#define PG8_GLOAD(dst, u) do { _Pragma("unroll") for (int h_ = 0; h_ < 2; ++h_) _Pragma("unroll") for (int i_ = 0; i_ < 2; ++i_) \
        dst[h_][i_] = (unsigned)gidx[(u).pm * BM + h_ * HALF + (int)(rcA[i_] & 0xffffu)] * (unsigned)(K * 2) + (rcA[i_] >> 16); } while (0)
#define PG8_STAGE_A(bufoff, gbase, h, nx) do { if constexpr (GATHER) { unsigned vs_[2] = {(nx) ? gN[h][0] : gC[h][0], (nx) ? gN[h][1] : gC[h][1]}; PG8_STAGE(bufoff, gbase, vs_); } \
        else { PG8_STAGE(bufoff, (gbase) + ((h) ? hstep : 0), voffA); } } while (0)
    const size_t kstep = (size_t)(BK * 2);
    const size_t hstep = (size_t)HALF * K * 2;
    const size_t tstep = 2 * hstep;
    const unsigned ldsw = (unsigned)wid * 1024u;
    const int aoff = lds_byte(wr * 64 + fr, fq * 8), boff = lds_byte(wc * 32 + fr, fq * 8);
#define PG8_SA(b, h) (((b) * 2 + (h)) * HTB)
#define PG8_SB(b, h) ((4 + (b) * 2 + (h)) * HTB)
#define PG8_STAGE(bufoff, gbase, voff) do { _Pragma("unroll") for (int _i = 0; _i < 2; ++_i) \
        __builtin_amdgcn_global_load_lds((const unsigned*)((const char*)(gbase) + (voff)[_i]), (PG8_LAS unsigned*)(lds + (bufoff) + ldsw + _i * 8192), 16, 0, 0); } while (0)
#define PG8_LDA(dst, b, h) do { _Pragma("unroll") for (int m = 0; m < 4; ++m) _Pragma("unroll") for (int k = 0; k < 2; ++k) dst[m][k] = *(const PG8_LAS bf16x8*)(lds + PG8_SA(b, h) + aoff + m * 2048 + k * 1024); } while (0)
#define PG8_LDB(dst, b, h) do { _Pragma("unroll") for (int n = 0; n < 2; ++n) _Pragma("unroll") for (int k = 0; k < 2; ++k) dst[n][k] = *(const PG8_LAS bf16x8*)(lds + PG8_SB(b, h) + boff + n * 2048 + k * 1024); } while (0)
#define PG8_MMA(ai, bj, At, Bt) do { __builtin_amdgcn_s_setprio(1); _Pragma("unroll") for (int m = 0; m < 4; ++m) _Pragma("unroll") for (int n = 0; n < 2; ++n) _Pragma("unroll") for (int k = 0; k < 2; ++k) \
        acc[ai][bj][m][n] = __builtin_amdgcn_mfma_f32_16x16x32_bf16(Bt[n][k], At[m][k], acc[ai][bj][m][n], 0, 0, 0); __builtin_amdgcn_s_setprio(0); } while (0)
#define PG8_WAIT_V(n) asm volatile("s_waitcnt vmcnt(" #n ")" ::: "memory")
#define PG8_WAIT_L(n) asm volatile("s_waitcnt lgkmcnt(" #n ")" ::: "memory")
#define PG8_BAR __builtin_amdgcn_s_barrier()
#define PG8_SCHED __builtin_amdgcn_sched_barrier(0)
    Unit cur, nxt; int ui = 0;
    if (!S.next(0, cur)) return;
    f32x4 acc[2][2][4][2];
#pragma unroll
    for (int a = 0; a < 2; ++a)
#pragma unroll
        for (int b = 0; b < 2; ++b)
#pragma unroll
            for (int m = 0; m < 4; ++m)
#pragma unroll
                for (int n = 0; n < 2; ++n) acc[a][b][m][n] = (f32x4){0.f, 0.f, 0.f, 0.f};
    bf16x8 At[4][2], B0[2][2], B1[2][2];
    const char* cA = (const char*)g.A + (GATHER ? (size_t)0 : (size_t)cur.pm * tstep) + (size_t)cur.kt0 * kstep; const char* cB = (const char*)g.Bt + (size_t)cur.pn * tstep + (size_t)cur.kt0 * kstep;
    S.a_ready(cur);
    if constexpr (GATHER) PG8_GLOAD(gC, cur);
    if constexpr (SP2) {
        PG8_STAGE(PG8_SB(0, 0), cB, voffB); PG8_STAGE(PG8_SB(0, 1), cB + hstep, voffB); PG8_STAGE_A(PG8_SA(0, 0), cA, 0, false); PG8_STAGE_A(PG8_SA(0, 1), cA, 1, false);
        if (wr == 1) PG8_BAR;
        PG8_WAIT_V(2); PG8_BAR;
        PG8_STAGE(PG8_SB(1, 0), cB + kstep, voffB); PG8_STAGE_A(PG8_SA(1, 0), cA + kstep, 0, false); PG8_STAGE(PG8_SB(1, 1), cB + hstep + kstep, voffB);
        PG8_WAIT_V(6); PG8_BAR;
    } else {
        PG8_STAGE(PG8_SB(0, 0), cB, voffB); PG8_STAGE_A(PG8_SA(0, 0), cA, 0, false); PG8_STAGE(PG8_SB(0, 1), cB + hstep, voffB); PG8_STAGE_A(PG8_SA(0, 1), cA, 1, false);
        if (wr == 1) PG8_BAR;
        PG8_WAIT_V(4); PG8_BAR;
        PG8_STAGE(PG8_SB(1, 0), cB + kstep, voffB); PG8_STAGE_A(PG8_SA(1, 0), cA + kstep, 0, false); PG8_STAGE(PG8_SB(1, 1), cB + hstep + kstep, voffB);
        PG8_WAIT_V(6); PG8_BAR;
    }
    for (;;) {
        const bool has_next = S.next(ui + 1, nxt);
        const char* nA = (has_next && !GATHER) ? (const char*)g.A + (size_t)nxt.pm * tstep + (size_t)nxt.kt0 * kstep : cA; const char* nB = has_next ? (const char*)g.Bt + (size_t)nxt.pn * tstep + (size_t)nxt.kt0 * kstep : cB;
        const int ntc = cur.ntu ? cur.ntu : nt;
        if constexpr (GATHER) { if (has_next) PG8_GLOAD(gN, nxt); else { gN[0][0] = gC[0][0]; gN[0][1] = gC[0][1]; gN[1][0] = gC[1][0]; gN[1][1] = gC[1][1]; } }
#pragma unroll 1
        for (int t = 0; t < ntc; t += 2) {
            const bool last = (t == ntc - 2);
            const char* a1 = cA + (size_t)(t + 1) * kstep;
            const char* a2 = last ? nA : cA + (size_t)(t + 2) * kstep; const char* b2 = last ? nB : cB + (size_t)(t + 2) * kstep;
            const char* a3 = a2 + kstep; const char* b3 = b2 + kstep;
            if (last && has_next) S.a_ready(nxt);
            if constexpr (SP2) {
            PG8_LDB(B0, 0, 0); PG8_LDB(B1, 0, 1); PG8_SCHED; PG8_LDA(At, 0, 0); PG8_STAGE_A(PG8_SA(1, 1), a1, 1, false);
            PG8_WAIT_V(8); PG8_WAIT_L(0); PG8_BAR; PG8_MMA(0, 0, At, B0); PG8_MMA(0, 1, At, B1); PG8_BAR; PG8_SCHED;
            PG8_LDA(At, 0, 1); PG8_STAGE(PG8_SB(0, 0), b2, voffB); PG8_STAGE(PG8_SB(0, 1), b2 + hstep, voffB); PG8_STAGE_A(PG8_SA(0, 0), a2, 0, last);
            PG8_WAIT_V(8); PG8_WAIT_L(0); PG8_BAR; PG8_MMA(1, 0, At, B0); PG8_MMA(1, 1, At, B1); PG8_BAR; PG8_SCHED;
            PG8_LDB(B0, 1, 0); PG8_LDB(B1, 1, 1); PG8_SCHED; PG8_LDA(At, 1, 0); PG8_STAGE_A(PG8_SA(0, 1), a2, 1, last);
            PG8_WAIT_V(8); PG8_WAIT_L(0); PG8_BAR; PG8_MMA(0, 0, At, B0); PG8_MMA(0, 1, At, B1); PG8_BAR; PG8_SCHED;
            PG8_LDA(At, 1, 1); PG8_STAGE(PG8_SB(1, 0), b3, voffB); PG8_STAGE(PG8_SB(1, 1), b3 + hstep, voffB); PG8_STAGE_A(PG8_SA(1, 0), a3, 0, last);
            PG8_WAIT_V(8); PG8_WAIT_L(0); PG8_BAR; PG8_MMA(1, 0, At, B0); PG8_MMA(1, 1, At, B1); PG8_BAR; PG8_SCHED;
            } else {
            PG8_LDB(B0, 0, 0); PG8_SCHED; PG8_LDA(At, 0, 0); PG8_STAGE_A(PG8_SA(1, 1), a1, 1, false);
            PG8_WAIT_L(8); PG8_BAR; PG8_WAIT_L(0); PG8_MMA(0, 0, At, B0); PG8_BAR; PG8_SCHED;
            PG8_LDB(B1, 0, 1); PG8_STAGE(PG8_SB(0, 0), b2, voffB);
            PG8_BAR; PG8_WAIT_L(0); PG8_MMA(0, 1, At, B1); PG8_BAR;
            PG8_LDA(At, 0, 1); PG8_STAGE_A(PG8_SA(0, 0), a2, 0, last);
            PG8_BAR; PG8_WAIT_L(0); PG8_MMA(1, 0, At, B0); PG8_BAR; PG8_SCHED;
            PG8_STAGE(PG8_SB(0, 1), b2 + hstep, voffB);
            PG8_WAIT_V(6); PG8_BAR; PG8_MMA(1, 1, At, B1); PG8_BAR;
            PG8_LDB(B0, 1, 0); PG8_SCHED; PG8_LDA(At, 1, 0); PG8_STAGE_A(PG8_SA(0, 1), a2, 1, last);
            PG8_WAIT_L(8); PG8_BAR; PG8_WAIT_L(0); PG8_MMA(0, 0, At, B0); PG8_BAR; PG8_SCHED;
            PG8_LDB(B1, 1, 1); PG8_STAGE(PG8_SB(1, 0), b3, voffB);
            PG8_BAR; PG8_WAIT_L(0); PG8_MMA(0, 1, At, B1); PG8_BAR;
            PG8_LDA(At, 1, 1); PG8_STAGE_A(PG8_SA(1, 0), a3, 0, last);
            PG8_BAR; PG8_WAIT_L(0); PG8_MMA(1, 0, At, B0); PG8_BAR; PG8_SCHED;
            PG8_STAGE(PG8_SB(1, 1), b3 + hstep, voffB);
            PG8_WAIT_V(6); PG8_BAR; PG8_MMA(1, 1, At, B1); PG8_BAR;
            }
        }
        if constexpr (ALIGN_EPI) { if (wr == 0) PG8_BAR; }
        if constexpr (!Epi::AFTER_DRAIN) { int fr_e = fr, fq_e = fq; asm volatile("" : "+v"(fr_e), "+v"(fq_e)); E(acc, cur, wr, wc, fr_e, fq_e); S.done(cur); }
        if (!has_next) break;
#pragma unroll
        for (int a = 0; a < 2; ++a)
#pragma unroll
            for (int b = 0; b < 2; ++b)
#pragma unroll
                for (int m = 0; m < 4; ++m)
#pragma unroll
                    for (int n = 0; n < 2; ++n) acc[a][b][m][n] = (f32x4){0.f, 0.f, 0.f, 0.f};
        cur = nxt; cA = nA; cB = nB; ++ui;
        if constexpr (GATHER) { gC[0][0] = gN[0][0]; gC[0][1] = gN[0][1]; gC[1][0] = gN[1][0]; gC[1][1] = gN[1][1]; }
        if constexpr (ALIGN_EPI) { if (wr == 1) PG8_BAR; }
    }
    PG8_WAIT_V(0);
    if constexpr (!ALIGN_EPI) { if (wr == 0) PG8_BAR; }
    PG8_BAR;
    if constexpr (Epi::AFTER_DRAIN) { E.fused(acc, cur, wr, wc, fr, fq, lds, wid, lane); S.done(cur); }
#undef PG8_SA
#undef PG8_SB
#undef PG8_STAGE
#undef PG8_STAGE_A
#undef PG8_GLOAD
#undef PG8_LDA
#undef PG8_LDB
#undef PG8_MMA
#undef PG8_WAIT_V
#undef PG8_WAIT_L
#undef PG8_BAR
#undef PG8_SCHED
}
}

#define GAS __attribute__((address_space(1)))
#define LAS __attribute__((address_space(3)))
typedef unsigned short bf16;
typedef unsigned v4u __attribute__((ext_vector_type(4)));
typedef unsigned v2u __attribute__((ext_vector_type(2)));
typedef float f32x4 __attribute__((ext_vector_type(4)));
typedef float f32x2 __attribute__((ext_vector_type(2)));

constexpr int NB = 8, T = 4096, NC = 256, D = 1024, DEPTH = 4;
constexpr int MLAT = NB * T, MCTX = NB * NC, MALL = MLAT + MCTX;
constexpr int NP = 3072;
constexpr int HG_Q = 0, HG_I = 256, HG_ZF = 512, HG_ZB = 768, HG_G = 1024, ML_CQ = 1280, ML_CKV = 1536, ML_KR = 1664, NA_Q = 1792, NA_K = 2176, NA_V = 2560;
constexpr int NKT = 68;
constexpr int NQK = T + NC;
constexpr int NE = 16, CAPL = 512, CAPC = 32;
constexpr int XS_LAT = NB * NE * CAPL, XS_ROWS = XS_LAT + NB * NE * CAPC;
constexpr int NHS = 67;
constexpr float EPS = 1e-6f;
constexpr float LOG2E = 1.4426950408889634f;
constexpr float MLA_QS = 0.10206207261596577f * LOG2E;
constexpr float NA_QS = 0.125f * LOG2E;

constexpr size_t MiB = 1u << 20;
constexpr size_t WS_CTL = 0, CTL_BYTES = 1 * MiB;
constexpr size_t WS_MOD = 1 * MiB;
constexpr size_t WS_LB = 2 * MiB;
constexpr size_t WS_ROPE = 2 * MiB + 65536;
constexpr size_t WS_WIN = 3 * MiB;
constexpr size_t WS_WMLA = 9 * MiB;
constexpr size_t WS_WOUT = 11 * MiB;
constexpr size_t WS_W13 = 13 * MiB;
constexpr size_t WS_W2 = 77 * MiB;
constexpr size_t WS_X = 109 * MiB;
constexpr size_t WS_H = 245 * MiB;
constexpr size_t WS_MIX = 313 * MiB;
constexpr size_t WS_AFF = 381 * MiB;
constexpr size_t WS_IDX = 384 * MiB;
constexpr size_t WS_GV = 384 * MiB + 512 * 1024;
constexpr size_t WS_SEL = 823 * MiB;
constexpr size_t WS_P = 385 * MiB;
constexpr size_t WS_AM = 589 * MiB;
constexpr size_t WS_QM = 615 * MiB;
constexpr size_t WS_KM = 654 * MiB;
constexpr size_t WS_VM = 693 * MiB;
constexpr size_t WS_HU = 719 * MiB;
constexpr size_t WS_HD = 787 * MiB;
constexpr size_t WS_OF = 789 * MiB;
constexpr size_t WS_XS = 385 * MiB;
constexpr size_t WS_ACT = 521 * MiB;
constexpr size_t WS_Y = WS_XS;
constexpr size_t WS_END = 826 * MiB;

constexpr int RING_BYTES = 155648, MISC_OFF = RING_BYTES, LDS_BYTES = RING_BYTES + 1024;
constexpr int NPH_LAYER = 10, NPHASES = 1 + DEPTH * NPH_LAYER + 1;

struct KP { const float* in[22]; float* out; unsigned char* ws; int ph_lo, ph_hi, li, pad; };
typedef const __attribute__((address_space(4))) KP* KA;

__device__ __forceinline__ float bf2f(unsigned u) { return __uint_as_float(u << 16); }
__device__ __forceinline__ unsigned f2bf(float f) { unsigned u = __float_as_uint(f); return (u + 0x7fffu + ((u >> 16) & 1u)) >> 16; }
__device__ __forceinline__ unsigned pk2(float lo, float hi) { return f2bf(lo) | (f2bf(hi) << 16); }
typedef float f32x2_t __attribute__((ext_vector_type(2)));
typedef __bf16 bf16x2_t __attribute__((ext_vector_type(2)));
__device__ __forceinline__ unsigned cvtpk(float lo, float hi) { f32x2_t v = {lo, hi}; bf16x2_t b = __builtin_convertvector(v, bf16x2_t); return __builtin_bit_cast(unsigned, b); }
__device__ __forceinline__ int lane_id_asm() { int l; asm volatile("v_mbcnt_lo_u32_b32 %0, -1, 0\n\tv_mbcnt_hi_u32_b32 %0, -1, %0" : "=v"(l)); return l; }
#define DPP_F(v, ctrl) __int_as_float(__builtin_amdgcn_update_dpp(0, __float_as_int(v), (ctrl), 0xf, 0xf, true))
#define DPP_I(v, ctrl) __builtin_amdgcn_update_dpp(0, (int)(v), (ctrl), 0xf, 0xf, true)
__device__ __forceinline__ float rdlane(float v, int l) { return __int_as_float(__builtin_amdgcn_readlane(__float_as_int(v), l)); }
__device__ __forceinline__ float wave_sum(float v) {
    v += DPP_F(v, 0xB1); v += DPP_F(v, 0x4E); v += DPP_F(v, 0x141); v += DPP_F(v, 0x140);
    return (rdlane(v, 0) + rdlane(v, 16)) + (rdlane(v, 32) + rdlane(v, 48));
}
__device__ __forceinline__ float wave_max(float v) {
    v = fmaxf(v, DPP_F(v, 0xB1)); v = fmaxf(v, DPP_F(v, 0x4E)); v = fmaxf(v, DPP_F(v, 0x141)); v = fmaxf(v, DPP_F(v, 0x140));
    return fmaxf(fmaxf(rdlane(v, 0), rdlane(v, 16)), fmaxf(rdlane(v, 32), rdlane(v, 48)));
}
__device__ __forceinline__ unsigned wave_sum_u(unsigned v) {
    v += (unsigned)DPP_I(v, 0xB1); v += (unsigned)DPP_I(v, 0x4E); v += (unsigned)DPP_I(v, 0x141); v += (unsigned)DPP_I(v, 0x140);
    return (unsigned)(__builtin_amdgcn_readlane((int)v, 0) + __builtin_amdgcn_readlane((int)v, 16) + __builtin_amdgcn_readlane((int)v, 32) + __builtin_amdgcn_readlane((int)v, 48));
}
__device__ __forceinline__ unsigned wave_incl_scan_u(unsigned v, int lane) {
    v += (unsigned)DPP_I(v, 0x111); v += (unsigned)DPP_I(v, 0x112); v += (unsigned)DPP_I(v, 0x114); v += (unsigned)DPP_I(v, 0x118);
    const unsigned t0 = (unsigned)__builtin_amdgcn_readlane((int)v, 15), t1 = (unsigned)__builtin_amdgcn_readlane((int)v, 31), t2 = (unsigned)__builtin_amdgcn_readlane((int)v, 47);
    const int r = lane >> 4; return v + (r > 0 ? t0 : 0u) + (r > 1 ? t1 : 0u) + (r > 2 ? t2 : 0u);
}
__device__ __forceinline__ float sigmoidf_(float v) { return 1.f / (1.f + expf(-v)); }
__device__ __forceinline__ void unpack8(const v4u k, float* o) {
    o[0] = bf2f(k.x & 0xffffu); o[1] = bf2f(k.x >> 16); o[2] = bf2f(k.y & 0xffffu); o[3] = bf2f(k.y >> 16); o[4] = bf2f(k.z & 0xffffu); o[5] = bf2f(k.z >> 16); o[6] = bf2f(k.w & 0xffffu); o[7] = bf2f(k.w >> 16);
}
#define LDS_WAIT() asm volatile("s_waitcnt lgkmcnt(0)" ::: "memory")
#define XB_TMO      128
#define XB_XCNT(j)  (256  + 64 * (j))
#define XB_XSUB(j)  (1280 + 64 * (j))
#define XB_XGEN(j)  (2304 + 64 * (j))
#define XB_TOP      3328
#define XB_TOPGEN   3392
#define XCD_BAR_WORDS 3456
#define XB_SPIN_CAP (1u << 18)

__device__ __forceinline__ unsigned xb_ld(unsigned* p)              { return __hip_atomic_load(p, __ATOMIC_RELAXED, __HIP_MEMORY_SCOPE_AGENT); }
__device__ __forceinline__ unsigned xb_add(unsigned* p, unsigned v) { return __hip_atomic_fetch_add(p, v, __ATOMIC_RELAXED, __HIP_MEMORY_SCOPE_AGENT); }
__device__ __forceinline__ unsigned xb_xcc_id() { return (unsigned)__builtin_amdgcn_s_getreg((3 << 11) | 20) & 0xFu; }
#define XB_SPIN(cond, bar) do { unsigned _sp = 0; while (cond) { __builtin_amdgcn_s_sleep(1); \
    if ((++_sp & 255u) == 0u) { if (xb_ld(&(bar)[XB_TMO])) break; if (_sp > XB_SPIN_CAP) { atomicAdd(&(bar)[XB_TMO], 1u); break; } } } } while (0)

struct XcdBarrier {
    unsigned* bar; unsigned x;
    volatile LAS unsigned* st;
};

__device__ __forceinline__ XcdBarrier xcd_barrier_post(unsigned* bar, volatile LAS unsigned* st) {
    XcdBarrier b; b.bar = bar; b.x = xb_xcc_id(); b.st = st;
    if (threadIdx.x == 0) (void)xb_add(&bar[XB_XCNT(b.x)], 1u);
    return b;
}
__device__ __forceinline__ void xcd_barrier_complete(unsigned* bar, unsigned x, unsigned& nloc, unsigned& nx) {
    const unsigned G = gridDim.x * gridDim.y * gridDim.z;
    unsigned sum, cnt, mine, sp = 0u;
    for (;;) {
        sum = 0u; cnt = 0u; mine = 0u;
#pragma unroll
        for (unsigned j = 0; j < 16; ++j) { const unsigned c = xb_ld(&bar[XB_XCNT(j)]); sum += c; cnt += (c > 0u) ? 1u : 0u; mine = (j == x) ? c : mine; }
        if (sum == G) break;
        __builtin_amdgcn_s_sleep(1);
        if ((++sp & 255u) == 0u) { if (xb_ld(&bar[XB_TMO])) break; if (sp > XB_SPIN_CAP) { atomicAdd(&bar[XB_TMO], 1u); break; } }
    }
    nloc = mine > 0u ? mine : 1u; nx = cnt > 0u ? cnt : 1u;
}

__device__ __attribute__((noinline)) void xcd_barrier(const XcdBarrier b, const bool leader_thread) {
    asm volatile("s_waitcnt vmcnt(0)" ::: "memory");
    __syncthreads();
    if (leader_thread) {
        unsigned* bar = b.bar;
        __builtin_amdgcn_s_waitcnt(0);
        unsigned nloc = b.st[0], nx = b.st[1];
        if (nloc == 0u) { xcd_barrier_complete(bar, b.x, nloc, nx); b.st[0] = nloc; b.st[1] = nx; }
        const unsigned old = xb_add(&bar[XB_XSUB(b.x)], 1u);
        const unsigned gen = old / nloc;
        if (old + 1u == (gen + 1u) * nloc) {
            __builtin_amdgcn_fence(__ATOMIC_RELEASE, "agent");
            asm volatile("s_waitcnt vmcnt(0)" ::: "memory");
            const unsigned og = xb_add(&bar[XB_TOP], 1u);
            const unsigned tg = og / nx;
            if (og + 1u == (tg + 1u) * nx) xb_add(&bar[XB_TOPGEN], 1u);
            else XB_SPIN(xb_ld(&bar[XB_TOPGEN]) == tg, bar);
            __builtin_amdgcn_fence(__ATOMIC_ACQUIRE, "agent");
            xb_add(&bar[XB_XGEN(b.x)], 1u);
            asm volatile("s_waitcnt vmcnt(0)" ::: "memory");
        } else {
            XB_SPIN(xb_ld(&bar[XB_XGEN(b.x)]) == gen, bar);
            __builtin_amdgcn_fence(__ATOMIC_ACQUIRE, "agent");
            asm volatile("s_waitcnt vmcnt(0)" ::: "memory");
        }
    }
    __syncthreads();
}

struct Ctx {
    LAS unsigned char* lds; unsigned char* ws; int tid, lane, wave, G, gw, NGW;
};

__device__ __forceinline__ void ph_prologue(KA p, const Ctx& c) {
    LAS float* sL = (LAS float*)c.lds;
    LAS float* red = (LAS float*)(c.lds + 9 * 1024 * 4);
    const float* cv = p->in[1]; const float* cc = p->in[3];
    for (int i = c.tid; i < 9 * 1024; i += 512) { const int bi = i >> 10, k = i & 1023; const float v = bi < 8 ? cv[bi * 1024 + k] : cc[k]; sL[i] = v * sigmoidf_(v); }
    __syncthreads();
    float* MOD = (float*)(c.ws + WS_MOD);
    for (int item = blockIdx.x; item < DEPTH * 96; item += c.G) {
        const int layer = item / 96, cg = item % 96, col = cg * 64 + c.lane;
        const float* W = p->in[4] + (size_t)layer * 1024 * 6144 + col;
        float acc[9];
#pragma unroll
        for (int bi = 0; bi < 9; ++bi) acc[bi] = 0.f;
#pragma unroll 1
        for (int kb = 0; kb < 128; kb += 32) {
            float wv[32];
#pragma unroll
            for (int kk = 0; kk < 32; ++kk) wv[kk] = __builtin_nontemporal_load(W + (size_t)(c.wave * 128 + kb + kk) * 6144);
#pragma unroll
            for (int kk = 0; kk < 32; ++kk) { const int k = c.wave * 128 + kb + kk;
#pragma unroll
                for (int bi = 0; bi < 9; ++bi) acc[bi] += sL[bi * 1024 + k] * wv[kk]; } }
#pragma unroll
        for (int bi = 0; bi < 9; ++bi) red[(c.wave * 9 + bi) * 64 + c.lane] = acc[bi];
        __syncthreads();
        for (int i = c.tid; i < 576; i += 512) { const int bi = i >> 6, l = i & 63; float s = 0.f;
#pragma unroll
            for (int w = 0; w < 8; ++w) s += red[(w * 9 + bi) * 64 + l];
            MOD[(size_t)(layer * 9 + bi) * 6144 + cg * 64 + l] = s + p->in[5][layer * 6144 + cg * 64 + l]; }
        __syncthreads();
    }
    if (blockIdx.x == c.G - 1) {
        const int dr = c.tid >> 8, ch = c.tid & 255; const float* lg = p->in[9] + dr * DEPTH * 256 + ch;
        const float l0 = lg[0], l1 = lg[256], l2 = lg[512], l3 = lg[768]; const float mx = fmaxf(fmaxf(l0, l1), fmaxf(l2, l3));
        const float e0 = expf(l0 - mx), e1 = expf(l1 - mx), e2 = expf(l2 - mx), e3 = expf(l3 - mx), inv = 1.f / (e0 + e1 + e2 + e3);
        float* LB = (float*)(c.ws + WS_LB) + dr * DEPTH * 256 + ch;
        LB[0] = 0.f; LB[256] = e1 * inv; LB[512] = (e1 + e2) * inv; LB[768] = (e1 + e2 + e3) * inv;
    }
    if (blockIdx.x == c.G - 2) {
        const int pos = c.tid >> 3, fi = c.tid & 7;
        const float inv = exp2f(-(float)fi * 1.6609640474436813f);
        const float angf = (float)pos * inv;
        double r = (double)angf; const double TWO_PI = 6.283185307179586476925; r -= TWO_PI * __builtin_rint(r / TWO_PI);
        const double r2 = r * r; double cs = 1.0, sn = r, tc = 1.0, ts = r;
        for (int k = 1; k <= 14; ++k) { tc *= -r2 / (double)((2 * k - 1) * (2 * k)); ts *= -r2 / (double)((2 * k) * (2 * k + 1)); cs += tc; sn += ts; }
        float* RT = (float*)(c.ws + WS_ROPE); RT[c.tid * 2] = (float)cs; RT[c.tid * 2 + 1] = (float)sn;
    }
}

__device__ __forceinline__ void transpose_item(const float* W, int N, bf16* WT, int Kd, int k0, int n0, int drow0, LAS float* scr, int lane) {
    f32x4 wv[8];
#pragma unroll
    for (int i = 0; i < 8; ++i) wv[i] = __builtin_nontemporal_load((const f32x4*)(W + (size_t)(k0 + 8 * i + (lane >> 3)) * N + n0 + 4 * (lane & 7)));
#pragma unroll
    for (int i = 0; i < 8; ++i) { LAS float* d = scr + (8 * i + (lane >> 3)) * 33 + 4 * (lane & 7); d[0] = wv[i].x; d[1] = wv[i].y; d[2] = wv[i].z; d[3] = wv[i].w; }
    LDS_WAIT(); asm volatile("" ::: "memory");
    const int ch = lane & 7;
#pragma unroll
    for (int j = 0; j < 4; ++j) { const int n = (lane >> 3) + 8 * j; const LAS float* s = scr + (8 * ch) * 33 + n;
        v4u o; o.x = cvtpk(s[0 * 33], s[1 * 33]); o.y = cvtpk(s[2 * 33], s[3 * 33]); o.z = cvtpk(s[4 * 33], s[5 * 33]); o.w = cvtpk(s[6 * 33], s[7 * 33]);
        *(v4u*)(WT + (size_t)(drow0 + n) * Kd + k0 + 8 * ch) = o; }
    LDS_WAIT(); asm volatile("" ::: "memory");
}
__device__ __forceinline__ int rope_rho(int p) { return 16 * (p >> 4) + 8 * ((p >> 2) & 1) + 4 * ((p >> 3) & 1) + (p & 3); }

__device__ __forceinline__ void ph_convert(KA p, const Ctx& c, int layer) {
    LAS float* scr = (LAS float*)(c.lds + c.wave * 16384);
    constexpr int I_WIN = 16 * 89, I_WOUT = 16 * 32, I_EXP = 16 * 32;
    constexpr int NIT = I_WIN + I_WOUT + 3 * NE * I_EXP;
    bf16* WIN = (bf16*)(c.ws + WS_WIN); bf16* WOUT = (bf16*)(c.ws + WS_WOUT); bf16* W13 = (bf16*)(c.ws + WS_W13); bf16* W2 = (bf16*)(c.ws + WS_W2);
    for (int it = c.gw; it < NIT; it += c.NGW) {
        int r = it;
        if (r < I_WIN) { const int kb = r / 89, nb = r % 89, n0 = 32 * nb; transpose_item(p->in[8] + (size_t)layer * 1024 * 2848, 2848, WIN, 1024, 64 * kb, n0, n0 + (n0 >= 1696 ? 96 : 0), scr, c.lane); continue; }
        r -= I_WIN;
        if (r < I_WOUT) { const int kb = r >> 5, nb = r & 31; transpose_item(p->in[16] + (size_t)layer * 1024 * 1024, 1024, WOUT, 1024, 64 * kb, 32 * nb, 32 * nb, scr, c.lane); continue; }
        r -= I_WOUT;
        const int which = r / (NE * I_EXP); r -= which * (NE * I_EXP);
        const int e = r >> 9, rr = r & 511, kb = rr >> 5, nb = rr & 31, n0 = 32 * nb;
        const size_t woff = ((size_t)layer * NE + e) * 1024 * 1024;
        if (which == 0) transpose_item(p->in[18] + woff, 1024, W13 + (size_t)e * 2048 * 1024, 1024, 64 * kb, n0, 256 * (n0 >> 7) + (n0 & 127), scr, c.lane);
        else if (which == 1) transpose_item(p->in[19] + woff, 1024, W13 + (size_t)e * 2048 * 1024, 1024, 64 * kb, n0, 256 * (n0 >> 7) + 128 + (n0 & 127), scr, c.lane);
        else transpose_item(p->in[20] + woff, 1024, W2 + (size_t)e * 1024 * 1024, 1024, 64 * kb, n0, n0, scr, c.lane);
    }
    const int gt = blockIdx.x * 512 + c.tid, NGT = c.G * 512;
    for (int i = gt; i < 224 * 128; i += NGT) { const int rw = i >> 7, cq = i & 127; const int row = rw < 96 ? 1696 + rw : 2944 + (rw - 96);
        unsigned z = 0u; asm volatile("" : "+v"(z));
        *(v4u*)(WIN + (size_t)row * 1024 + cq * 8) = (v4u){z, z, z, z}; }
    bf16* WM = (bf16*)(c.ws + WS_WMLA);
    const float* wuq = p->in[12] + (size_t)layer * 256 * 576; const float* wukv = p->in[14] + (size_t)layer * 128 * 768;
#pragma unroll 1
    for (int i0 = gt; i0 < 1536 * 384; i0 += 5 * NGT) { float vv[5];
#pragma unroll
        for (int t = 0; t < 5; ++t) { const int i = i0 + t * NGT; float v = 0.f;
            if (i < 1536 * 384) { const int n = i / 384, k = i - n * 384;
                if (n < 768) { const int h = n >> 7, ci = n & 127; if (ci < 96 && k < 256) { const int dim = ci < 64 ? ci : 64 + rope_rho(ci - 64); v = wuq[(size_t)k * 576 + h * 96 + dim]; } }
                else { if (k >= 256) v = wukv[(size_t)(k - 256) * 768 + (n - 768)]; } }
            vv[t] = v; }
#pragma unroll
        for (int t = 0; t < 5; ++t) { const int i = i0 + t * NGT; if (i < 1536 * 384) WM[i] = (bf16)f2bf(vv[t]); } }
}

__device__ __forceinline__ void combine_row(const Ctx& c, int layer, int row, int bi, f32x4 (&v)[4], bool write_x) {
    const int* SEL = (const int*)(c.ws + WS_SEL); const float* GV = (const float*)(c.ws + WS_GV); const bf16* Y = (const bf16*)(c.ws + WS_Y);
    const float* gf = (const float*)(c.ws + WS_MOD) + (size_t)(layer * 9 + bi) * 6144 + 5120;
    const int sel = SEL[(size_t)row * 16 + (c.lane & 15)];
    f32x4 a[4], gfv[4];
#pragma unroll
    for (int j = 0; j < 4; ++j) gfv[j] = *(const f32x4*)(gf + c.lane * 4 + 256 * j);
#pragma unroll
    for (int j = 0; j < 4; ++j) a[j] = (f32x4){0.f, 0.f, 0.f, 0.f};
    unsigned mask = (unsigned)(__ballot(sel >= 0) & 0xffffull);
#pragma unroll 1
    while (mask) {
        const int e1 = __builtin_ctz(mask); mask &= mask - 1u; const bool two = mask != 0u; const int e2 = two ? __builtin_ctz(mask) : e1; mask &= mask - 1u;
        const int xs1 = __builtin_amdgcn_readlane(sel, e1), xs2 = __builtin_amdgcn_readlane(sel, e2);
        const float g1 = GV[xs1], g2 = two ? GV[xs2] : 0.f; const bf16* y1 = Y + (size_t)xs1 * 1024 + c.lane * 4; const bf16* y2 = Y + (size_t)xs2 * 1024 + c.lane * 4;
        v2u w1[4], w2[4];
#pragma unroll
        for (int j = 0; j < 4; ++j) { w1[j] = *(const v2u*)(y1 + 256 * j); w2[j] = *(const v2u*)(y2 + 256 * j); }
#pragma unroll
        for (int j = 0; j < 4; ++j) { a[j] += g1 * (f32x4){bf2f(w1[j].x & 0xffffu), bf2f(w1[j].x >> 16), bf2f(w1[j].y & 0xffffu), bf2f(w1[j].y >> 16)};
                                      a[j] += g2 * (f32x4){bf2f(w2[j].x & 0xffffu), bf2f(w2[j].x >> 16), bf2f(w2[j].y & 0xffffu), bf2f(w2[j].y >> 16)}; }
    }
    bf16* X = (bf16*)(c.ws + WS_X) + (size_t)row * 1024;
#pragma unroll
    for (int j = 0; j < 4; ++j) { const int col = c.lane * 4 + 256 * j; v[j] += gfv[j] * a[j]; if (write_x) *(v2u*)(X + col) = (v2u){cvtpk(v[j].x, v[j].y), cvtpk(v[j].z, v[j].w)}; }
}

template <bool ROUTER, bool COMBINE, bool DRY = false>
__device__ __forceinline__ void ph_norm(KA p, const Ctx& c, int layer, const float* xlat, const float* xctx, int nrows) {
    const float* MOD = (const float*)(c.ws + WS_MOD) + (size_t)layer * 9 * 6144;
    const float* gain = (ROUTER ? p->in[7] : p->in[6]) + layer * 1024;
    const int o_sh = ROUTER ? 3072 : 0, o_sc = ROUTER ? 4096 : 1024;
    bf16* H = (bf16*)(c.ws + WS_H); float* AFF = (float*)(c.ws + WS_AFF);
    LAS float* RWT = (LAS float*)c.lds;
    if (ROUTER) { const float* rw = p->in[17] + (size_t)layer * 1024 * 16;
        for (int i = c.tid; i < 16384; i += 512) { const int col = i >> 4, e = i & 15; RWT[e * 1024 + col] = rw[i]; }
        __syncthreads(); }
    for (int row = c.gw; row < nrows; row += c.NGW) {
        asm volatile("" ::: "memory");
        const bf16* xr = (const bf16*)(c.ws + WS_X) + (size_t)row * 1024;
        const int bi = row < MLAT ? (row >> 12) : 8; const float* mp = MOD + bi * 6144;
        f32x4 v[4]; float ss = 0.f;
#pragma unroll
        for (int j = 0; j < 4; ++j) { const v2u w = *(const v2u*)(xr + c.lane * 4 + 256 * j); v[j] = (f32x4){bf2f(w.x & 0xffffu), bf2f(w.x >> 16), bf2f(w.y & 0xffffu), bf2f(w.y >> 16)}; }
        f32x4 mg[4], msc[4], msh[4];
#pragma unroll
        for (int j = 0; j < 4; ++j) { const int col = c.lane * 4 + 256 * j; mg[j] = *(const f32x4*)(gain + col); msc[j] = *(const f32x4*)(mp + o_sc + col); msh[j] = *(const f32x4*)(mp + o_sh + col); }
        if (COMBINE) combine_row(c, layer - 1, row, bi, v, !DRY);
#pragma unroll
        for (int j = 0; j < 4; ++j) ss += (v[j].x * v[j].x + v[j].y * v[j].y) + (v[j].z * v[j].z + v[j].w * v[j].w);
        const float rstd = rsqrtf(wave_sum(ss) * (1.f / 1024.f) + EPS);
#pragma unroll
        for (int j = 0; j < 4; ++j) { const int col = c.lane * 4 + 256 * j;
            const f32x4 g = mg[j], sc = msc[j], sh = msh[j];
            v[j] = v[j] * rstd * g * (1.f + sc) + sh;
            *(v2u*)(H + (size_t)row * 1024 + col) = (v2u){cvtpk(v[j].x, v[j].y), cvtpk(v[j].z, v[j].w)}; }
        if (ROUTER) {
            float lg[16];
#pragma unroll
            for (int e = 0; e < 16; ++e) { float a = 0.f;
#pragma unroll
                for (int j = 0; j < 4; ++j) { const f32x4 w = *(const LAS f32x4*)(RWT + e * 1024 + c.lane * 4 + 256 * j); a += (v[j].x * w.x + v[j].y * w.y) + (v[j].z * w.z + v[j].w * w.w); }
                lg[e] = wave_sum(a); }
            float mx = lg[0];
#pragma unroll
            for (int e = 1; e < 16; ++e) mx = fmaxf(mx, lg[e]);
            float sm = 0.f;
#pragma unroll
            for (int e = 0; e < 16; ++e) { lg[e] = expf(lg[e] - mx); sm += lg[e]; }
            const float inv = 1.f / sm; float mine = 0.f;
#pragma unroll
            for (int e = 0; e < 16; ++e) mine = (c.lane == e) ? lg[e] * inv : mine;
            if (c.lane < 16) { AFF[(size_t)row * 16 + c.lane] = mine; ((int*)(c.ws + WS_SEL))[(size_t)row * 16 + c.lane] = -1; }
        }
    }
}

__device__ __forceinline__ float row16_sum_n(float v) { v += DPP_F(v, 0xB1); v += DPP_F(v, 0x4E); v += DPP_F(v, 0x141); v += DPP_F(v, 0x140); return v; }
template <bool ROUTER, bool XBF>
__device__ __forceinline__ void ph_norm4(KA p, const Ctx& c, int layer, const float* xlat, const float* xctx, int nrows) {
    const float* MODb = (const float*)(c.ws + WS_MOD) + (size_t)layer * 9 * 6144;
    const float* gain = (ROUTER ? p->in[7] : p->in[6]) + layer * 1024;
    const int o_sh = ROUTER ? 3072 : 0, o_sc = ROUTER ? 4096 : 1024;
    bf16* H = (bf16*)(c.ws + WS_H); float* AFF = (float*)(c.ws + WS_AFF); int* SEL = (int*)(c.ws + WS_SEL);
    LAS float* RWT = (LAS float*)c.lds;
    if (ROUTER) { const float* rw = p->in[17] + (size_t)layer * 1024 * 16;
        for (int i = c.tid; i < 16384; i += 512) { const int col = i >> 4, e = i & 15; RWT[e * 1024 + col] = rw[i]; }
        __syncthreads(); }
    const int g = c.lane >> 4, l16 = c.lane & 15;
    const int gpw = (nrows / 4 + c.NGW - 1) / c.NGW;
    for (int rb = c.gw * gpw * 4, re = min(nrows, (c.gw + 1) * gpw * 4); rb < re; rb += 4) {
        asm volatile("" ::: "memory");
        const int row = rb + g;
        const float* xr = (row < MLAT ? xlat + (size_t)row * 1024 : xctx + (size_t)(row - MLAT) * 1024) + 4 * l16;
        const bf16* xb = (const bf16*)(c.ws + WS_X) + (size_t)row * 1024 + 4 * l16;
        const int bi = rb < MLAT ? (rb >> 12) : 8;
        f32x4 v[16]; float ss = 0.f;
#pragma unroll
        for (int j = 0; j < 16; ++j) { if (XBF) { const v2u w = *(const v2u*)(xb + 64 * j); v[j] = (f32x4){bf2f(w.x & 0xffffu), bf2f(w.x >> 16), bf2f(w.y & 0xffffu), bf2f(w.y >> 16)}; } else v[j] = *(const f32x4*)(xr + 64 * j); }
#pragma unroll
        for (int j = 0; j < 16; ++j) ss += (v[j].x * v[j].x + v[j].y * v[j].y) + (v[j].z * v[j].z + v[j].w * v[j].w);
        const float rstd = rsqrtf(row16_sum_n(ss) * (1.f / 1024.f) + EPS);
        const float* mp = MODb + (size_t)bi * 6144 + 4 * l16;
#pragma unroll
        for (int j = 0; j < 16; ++j) { const int col = 4 * l16 + 64 * j;
            const f32x4 gg = *(const f32x4*)(gain + col), sc = *(const f32x4*)(mp + o_sc + 64 * j), sh = *(const f32x4*)(mp + o_sh + 64 * j);
            v[j] = v[j] * rstd * gg * (1.f + sc) + sh;
            *(v2u*)(H + (size_t)row * 1024 + col) = (v2u){cvtpk(v[j].x, v[j].y), cvtpk(v[j].z, v[j].w)}; }
        if (ROUTER) {
            float lg[16];
#pragma unroll
            for (int e = 0; e < 16; ++e) { float acc = 0.f;
#pragma unroll
                for (int j = 0; j < 16; ++j) { const f32x4 w = *(const LAS f32x4*)(RWT + e * 1024 + 4 * l16 + 64 * j); acc += (v[j].x * w.x + v[j].y * w.y) + (v[j].z * w.z + v[j].w * w.w); }
                lg[e] = row16_sum_n(acc); }
            float mx = lg[0];
#pragma unroll
            for (int e = 1; e < 16; ++e) mx = fmaxf(mx, lg[e]);
            float sm = 0.f;
#pragma unroll
            for (int e = 0; e < 16; ++e) { lg[e] = expf(lg[e] - mx); sm += lg[e]; }
            const float inv = 1.f / sm; float mine = 0.f;
#pragma unroll
            for (int e = 0; e < 16; ++e) mine = (l16 == e) ? lg[e] * inv : mine;
            AFF[(size_t)row * 16 + l16] = mine; SEL[(size_t)row * 16 + l16] = -1;
        }
    }
}

__device__ __forceinline__ void ph_final(KA p, const Ctx& c) {
    const bf16* X = (const bf16*)(c.ws + WS_X); const float* g = p->in[21];
    f32x4 gv4[4];
#pragma unroll
    for (int j = 0; j < 4; ++j) gv4[j] = *(const f32x4*)(g + c.lane * 4 + 256 * j);
    for (int row = c.gw; row < MLAT; row += c.NGW) {
        const bf16* xr = X + (size_t)row * 1024; f32x4 v[4]; float ss = 0.f;
#pragma unroll
        for (int j = 0; j < 4; ++j) { const v2u w = *(const v2u*)(xr + c.lane * 4 + 256 * j); v[j] = (f32x4){bf2f(w.x & 0xffffu), bf2f(w.x >> 16), bf2f(w.y & 0xffffu), bf2f(w.y >> 16)}; }
        combine_row(c, DEPTH - 1, row, row >> 12, v, false);
#pragma unroll
        for (int j = 0; j < 4; ++j) ss += (v[j].x * v[j].x + v[j].y * v[j].y) + (v[j].z * v[j].z + v[j].w * v[j].w);
        const float rstd = rsqrtf(wave_sum(ss) * (1.f / 1024.f) + EPS);
#pragma unroll
        for (int j = 0; j < 4; ++j) { const int col = c.lane * 4 + 256 * j; *(f32x4*)(p->out + (size_t)row * 1024 + col) = v[j] * rstd * gv4[j]; }
    }
}

__device__ __forceinline__ void ph_mla_prep(KA p, const Ctx& c, int layer) {
    const bf16* P = (const bf16*)(c.ws + WS_P); bf16* AM = (bf16*)(c.ws + WS_AM); bf16* KM = (bf16*)(c.ws + WS_KM); const float* RT = (const float*)(c.ws + WS_ROPE);
    const float* gq = p->in[11] + layer * 256; const float* gkv = p->in[13] + layer * 128;
    const f32x4 g4 = *(const f32x4*)(gq + 4 * c.lane); const f32x2 g2 = *(const f32x2*)(gkv + 2 * c.lane);
    const int pp = c.lane & 31, fq = pp >> 3, n = (pp >> 2) & 1, i = pp & 3, half = fq >> 1, pair = 4 * (fq & 1) + i;
    constexpr int PB = 6;
#pragma unroll 1
    for (int row0 = c.gw; row0 < MALL; row0 += PB * c.NGW) {
        v2u qa[PB]; unsigned ka[PB]; unsigned short xa1[PB], xa2[PB]; f32x2 cs2[PB];
#pragma unroll
        for (int t = 0; t < PB; ++t) { const int row = row0 + t * c.NGW; if (row < MALL) { const bf16* pr = P + (size_t)row * NP;
            qa[t] = *(const v2u*)(pr + ML_CQ + 4 * c.lane); ka[t] = *(const unsigned*)(pr + ML_CKV + 2 * c.lane);
            xa1[t] = pr[ML_KR + 16 * half + pair]; xa2[t] = pr[ML_KR + 16 * half + 8 + pair];
            const int tk = row & 4095, pos = half ? (tk & 63) : (tk >> 6); cs2[t] = *(const f32x2*)(RT + (pos * 8 + pair) * 2); } }
#pragma unroll
        for (int t = 0; t < PB; ++t) { const int row = row0 + t * c.NGW; if (row < MALL) {
            const float q0 = bf2f(qa[t].x & 0xffffu), q1 = bf2f(qa[t].x >> 16), q2 = bf2f(qa[t].y & 0xffffu), q3 = bf2f(qa[t].y >> 16);
            const float rq = rsqrtf(wave_sum((q0 * q0 + q1 * q1) + (q2 * q2 + q3 * q3)) * (1.f / 256.f) + EPS);
            *(v2u*)(AM + (size_t)row * 384 + 4 * c.lane) = (v2u){cvtpk(q0 * rq * g4.x, q1 * rq * g4.y), cvtpk(q2 * rq * g4.z, q3 * rq * g4.w)};
            const float k0 = bf2f(ka[t] & 0xffffu), k1 = bf2f(ka[t] >> 16);
            const float rk = rsqrtf(wave_sum(k0 * k0 + k1 * k1) * (1.f / 128.f) + EPS);
            *(unsigned*)(AM + (size_t)row * 384 + 256 + 2 * c.lane) = cvtpk(k0 * rk * g2.x, k1 * rk * g2.y);
            if (c.lane < 32) {
                const float x1 = bf2f(xa1[t]), x2 = bf2f(xa2[t]);
                int b, kvi; float val;
                if (row < MLAT) { b = row >> 12; kvi = row & 4095; const float cs = cs2[t].x, sn = cs2[t].y; val = n ? (x2 * cs + x1 * sn) : (x1 * cs - x2 * sn); }
                else { const int rr = row - MLAT; b = rr >> 8; kvi = T + (rr & 255); val = n ? x2 : x1; }
                const bf16 vb = (bf16)f2bf(val); const int tile = kvi >> 6, kvr = kvi & 63;
#pragma unroll
                for (int h = 0; h < 6; ++h) KM[((size_t)((b * 6 + h) * NKT + tile) * 12 + 8 + fq) * 512 + kvr * 8 + (pp & 7)] = vb;
            } } }
    }
}

__device__ __forceinline__ int hg_row(int b, int cnat, int i) { return cnat < 4 ? MLAT + b * 256 + cnat * 64 + i : b * T + (cnat - 4) * 64 + i; }

__device__ __forceinline__ void ph_hgrn_pass1(KA p, const Ctx& c, int layer) {
    const bf16* P = (const bf16*)(c.ws + WS_P); float* HU = (float*)(c.ws + WS_HU); float* HD = (float*)(c.ws + WS_HD); const float* LB = (const float*)(c.ws + WS_LB);
    LAS float* fL = (LAS float*)(c.lds + c.wave * 16384); LAS float* kL = fL + 1024; LAS float* vL = fL + 2048;
    for (int item = c.gw; item < 64 * NHS; item += c.NGW) {
        const int seq = item / NHS, s = item - seq * NHS, dir = seq & 1, h = (seq >> 1) & 3, b = seq >> 3;
        const int cnat = dir ? (s < 4 ? 3 - s : 71 - s) : s;
        const float lbv = LB[(dir * DEPTH + layer) * 256 + h * 64 + c.lane];
        const int zcol = (dir ? HG_ZB : HG_ZF) + h * 64 + c.lane, vcol = HG_I + h * 64 + c.lane;
        float U[64];
#pragma unroll
        for (int d = 0; d < 64; ++d) U[d] = 0.f;
        float Dp = 1.f;
#pragma unroll 1
        for (int sb = 0; sb < 4; ++sb) {
#pragma unroll 4
            for (int tt = 0; tt < 16; ++tt) { const int i = sb * 16 + tt; const size_t ro = (size_t)hg_row(b, cnat, dir ? 63 - i : i) * NP;
                const float z = bf2f(P[ro + zcol]); const float f = fmaxf(lbv + (1.f - lbv) * sigmoidf_(z), 1e-20f);
                fL[tt * 64 + c.lane] = f; kL[tt * 64 + c.lane] = 1.f - f; vL[tt * 64 + c.lane] = bf2f(P[ro + vcol]); Dp *= f; }
            LDS_WAIT();
#pragma unroll 1
            for (int tt = 0; tt < 16; ++tt) { const float v = vL[tt * 64 + c.lane];
#pragma unroll
                for (int d4 = 0; d4 < 16; ++d4) { const f32x4 f4 = *(const LAS f32x4*)(fL + tt * 64 + d4 * 4), k4 = *(const LAS f32x4*)(kL + tt * 64 + d4 * 4);
                    U[4 * d4 + 0] = f4.x * U[4 * d4 + 0] + k4.x * v; U[4 * d4 + 1] = f4.y * U[4 * d4 + 1] + k4.y * v;
                    U[4 * d4 + 2] = f4.z * U[4 * d4 + 2] + k4.z * v; U[4 * d4 + 3] = f4.w * U[4 * d4 + 3] + k4.w * v; } }
            LDS_WAIT();
        }
        float* uo = HU + ((size_t)seq * NKT + s) * 4096 + c.lane;
#pragma unroll
        for (int d = 0; d < 64; ++d) uo[d * 64] = U[d];
        HD[((size_t)seq * NKT + s) * 64 + c.lane] = Dp;
    }
}

__device__ __forceinline__ void ph_hgrn_scan(const Ctx& c) {
    float* HU = (float*)(c.ws + WS_HU); const float* HD = (const float*)(c.ws + WS_HD);
    for (int el = blockIdx.x * 512 + c.tid; el < 64 * 4096; el += c.G * 512) {
        const int seq = el >> 12, de = el & 4095, d = de >> 6; float S = 0.f;
#pragma unroll 4
        for (int s = 0; s < NHS; ++s) { const size_t o = ((size_t)seq * NKT + s) * 4096 + de; const float u = HU[o], dc = HD[((size_t)seq * NKT + s) * 64 + d]; HU[o] = S; S = dc * S + u; }
        HU[((size_t)seq * NKT + NHS) * 4096 + de] = S;
    }
}

__device__ __forceinline__ void ph_hgrn_pass3(KA p, const Ctx& c, int layer, bool with_ctx) {
    const bf16* P = (const bf16*)(c.ws + WS_P); const float* HU = (const float*)(c.ws + WS_HU); const float* LB = (const float*)(c.ws + WS_LB);
    float* OF = (float*)(c.ws + WS_OF); bf16* MIX = (bf16*)(c.ws + WS_MIX);
    LAS float* fL = (LAS float*)(c.lds + c.wave * 16384); LAS float* kL = fL + 1024; LAS float* vL = fL + 2048; LAS float* qL = fL + 3072;
    const float og = p->in[10][layer * 64 + c.lane];
    const int c0 = with_ctx ? 0 : 4, nper = NKT - c0;
    for (int item = c.gw; item < 32 * nper; item += c.NGW) {
        const int bh = item / nper, cnat = c0 + (item - bh * nper), h = bh & 3, b = bh >> 2;
#pragma unroll 1
        for (int dir = 0; dir < 2; ++dir) {
            const int seq = bh * 2 + dir, s = dir ? (cnat < 4 ? 3 - cnat : 71 - cnat) : cnat;
            const float lbv = LB[(dir * DEPTH + layer) * 256 + h * 64 + c.lane];
            const int zcol = (dir ? HG_ZB : HG_ZF) + h * 64 + c.lane, vcol = HG_I + h * 64 + c.lane, qcol = HG_Q + h * 64 + c.lane, gcol = HG_G + h * 64 + c.lane;
            float S[64]; const float* si = HU + ((size_t)seq * NKT + s) * 4096 + c.lane;
#pragma unroll
            for (int d = 0; d < 64; ++d) S[d] = si[d * 64];
#pragma unroll 1
            for (int sb = 0; sb < 4; ++sb) {
#pragma unroll 4
                for (int tt = 0; tt < 16; ++tt) { const int i = sb * 16 + tt; const size_t ro = (size_t)hg_row(b, cnat, dir ? 63 - i : i) * NP;
                    const float z = bf2f(P[ro + zcol]); const float f = fmaxf(lbv + (1.f - lbv) * sigmoidf_(z), 1e-20f);
                    fL[tt * 64 + c.lane] = f; kL[tt * 64 + c.lane] = 1.f - f; vL[tt * 64 + c.lane] = bf2f(P[ro + vcol]); qL[tt * 64 + c.lane] = bf2f(P[ro + qcol]) * 0.125f; }
                LDS_WAIT();
#pragma unroll 1
                for (int tt = 0; tt < 16; ++tt) { const float v = vL[tt * 64 + c.lane]; float o0 = 0.f, o1 = 0.f;
#pragma unroll
                    for (int d4 = 0; d4 < 16; ++d4) { const f32x4 f4 = *(const LAS f32x4*)(fL + tt * 64 + d4 * 4), k4 = *(const LAS f32x4*)(kL + tt * 64 + d4 * 4), q4 = *(const LAS f32x4*)(qL + tt * 64 + d4 * 4);
                        S[4 * d4 + 0] = f4.x * S[4 * d4 + 0] + k4.x * v; S[4 * d4 + 1] = f4.y * S[4 * d4 + 1] + k4.y * v;
                        S[4 * d4 + 2] = f4.z * S[4 * d4 + 2] + k4.z * v; S[4 * d4 + 3] = f4.w * S[4 * d4 + 3] + k4.w * v;
                        o0 += q4.x * S[4 * d4 + 0] + q4.z * S[4 * d4 + 2]; o1 += q4.y * S[4 * d4 + 1] + q4.w * S[4 * d4 + 3]; }
                    const float o = o0 + o1; const int i = sb * 16 + tt; const int row = hg_row(b, cnat, dir ? 63 - i : i);
                    if (dir == 0) OF[(size_t)row * 256 + h * 64 + c.lane] = o;
                    else { const float tot = o + OF[(size_t)row * 256 + h * 64 + c.lane];
                        const float y = tot * rsqrtf(wave_sum(tot * tot) * (1.f / 64.f) + EPS) * og; const float g = bf2f(P[(size_t)row * NP + gcol]);
                        MIX[(size_t)row * 1024 + h * 64 + c.lane] = (bf16)f2bf(y * g * sigmoidf_(g)); } }
                LDS_WAIT();
            }
        }
    }
}

__device__ __forceinline__ void ph_attn_mla_simple(const Ctx& c, bool with_ctx) {
    const bf16* QM = (const bf16*)(c.ws + WS_QM); const bf16* KM = (const bf16*)(c.ws + WS_KM); const bf16* VM = (const bf16*)(c.ws + WS_VM); bf16* MIX = (bf16*)(c.ws + WS_MIX);
    const int nq = with_ctx ? NQK : T;
    for (int item = c.gw; item < 48 * nq; item += c.NGW) {
        const int bh = item / nq, qi = item - bh * nq, b = bh / 6, h = bh - b * 6; const bool isctx = qi >= T;
        float q[96];
#pragma unroll
        for (int ch = 0; ch < 12; ++ch) unpack8(*(const v4u*)(QM + ((size_t)bh * NQK + qi) * 96 + ch * 8), q + ch * 8);
        float m = -1e30f, l = 0.f, o = 0.f;
#pragma unroll 1
        for (int tile = isctx ? 64 : 0; tile < NKT; ++tile) {
            const bf16* kb = KM + (size_t)(bh * NKT + tile) * 12 * 512 + c.lane * 8; float s = 0.f;
#pragma unroll
            for (int ch = 0; ch < 12; ++ch) { float kk[8]; unpack8(*(const v4u*)(kb + ch * 512), kk);
#pragma unroll
                for (int i = 0; i < 8; ++i) s += q[ch * 8 + i] * kk[i]; }
            const float mn = fmaxf(m, wave_max(s)), pj = exp2f(s - mn), corr = exp2f(m - mn);
            l = l * corr + wave_sum(pj); o *= corr; m = mn;
            const bf16* vb = VM + (size_t)(bh * NKT + tile) * 2 * 2048 + (c.lane >> 5) * 2048 + (c.lane & 31);
#pragma unroll 8
            for (int j = 0; j < 64; ++j) o += rdlane(pj, j) * bf2f(vb[j * 32]);
        }
        const int row = isctx ? MLAT + b * 256 + (qi - T) : b * T + qi;
        MIX[(size_t)row * 1024 + 256 + h * 64 + c.lane] = (bf16)f2bf(o / l);
    }
}
__device__ __forceinline__ void ph_attn_na_simple(KA p, const Ctx& c, int layer, bool with_ctx) {
    const bf16* P = (const bf16*)(c.ws + WS_P); bf16* MIX = (bf16*)(c.ws + WS_MIX); const float* rpb = p->in[15] + (size_t)layer * 6 * 15 * 31;
    const int nq = with_ctx ? NQK : T;
    for (int item = c.gw; item < 48 * nq; item += c.NGW) {
        const int bh = item / nq, qi = item - bh * nq, b = bh / 6, h = bh - b * 6; const bool isctx = qi >= T;
        const int qrow = isctx ? MLAT + b * 256 + (qi - T) : b * T + qi;
        float q[64];
#pragma unroll
        for (int ch = 0; ch < 8; ++ch) unpack8(*(const v4u*)(P + (size_t)qrow * NP + NA_Q + h * 64 + ch * 8), q + ch * 8);
        const int r = qi >> 6, cc = qi & 63; const int rs = min(max(r - 4, 0), 56), cs = min(max(cc - 8, 0), 48);
        float m = -1e30f, l = 0.f, o = 0.f;
#pragma unroll 1
        for (int chunk = isctx ? 2 : 0; chunk < 6; ++chunk) {
            int krow; float bias = 0.f;
            if (chunk < 2) { const int w = chunk * 64 + c.lane, wr = w >> 4, wc = w & 15; krow = b * T + (rs + wr) * 64 + cs + wc; bias = rpb[(h * 15 + (rs + wr - r + 7)) * 31 + (cs + wc - cc + 15)]; }
            else krow = MLAT + b * 256 + (chunk - 2) * 64 + c.lane;
            const bf16* kb = P + (size_t)krow * NP + NA_K + h * 64; float s = 0.f;
#pragma unroll
            for (int ch = 0; ch < 8; ++ch) { float kk[8]; unpack8(*(const v4u*)(kb + ch * 8), kk);
#pragma unroll
                for (int i = 0; i < 8; ++i) s += q[ch * 8 + i] * kk[i]; }
            s = s * NA_QS + bias * LOG2E;
            const float mn = fmaxf(m, wave_max(s)), pj = exp2f(s - mn), corr = exp2f(m - mn);
            l = l * corr + wave_sum(pj); o *= corr; m = mn;
#pragma unroll 8
            for (int j = 0; j < 64; ++j) { int vrow; if (chunk < 2) { const int w = chunk * 64 + j; vrow = b * T + (rs + (w >> 4)) * 64 + cs + (w & 15); } else vrow = MLAT + b * 256 + (chunk - 2) * 64 + j;
                o += rdlane(pj, j) * bf2f(P[(size_t)vrow * NP + NA_V + h * 64 + c.lane]); }
        }
        MIX[(size_t)qrow * 1024 + 640 + h * 64 + c.lane] = (bf16)f2bf(o / l);
    }
}

__device__ __forceinline__ void ph_topk(const Ctx& c, bool with_ctx) {
    const float* AFF = (const float*)(c.ws + WS_AFF); const bf16* H = (const bf16*)(c.ws + WS_H); bf16* XS = (bf16*)(c.ws + WS_XS);
    float* GV = (float*)(c.ws + WS_GV);
    LAS unsigned* keys = (LAS unsigned*)c.lds;
    LAS unsigned* hist = keys + 4096;
    LAS unsigned* tot = hist + 2048;
    LAS unsigned* res = tot + 256;
    LAS unsigned* wtot = res + 16;
    LAS int* selL = (LAS int*)(wtot + 16);
    const int nitems = with_ctx ? 256 : 128;
    for (int item = blockIdx.x; item < nitems; item += c.G) {
        const bool lat = item < 128; const int be = lat ? item : item - 128, b = be >> 4, e = be & 15;
        const int ntok = lat ? T : NC, cap = lat ? CAPL : CAPC, rowbase = lat ? b * T : MLAT + b * NC, xs0 = lat ? be * CAPL : XS_LAT + (e * NB + b) * CAPC;
        const int per = lat ? 8 : 1;
        for (int i = c.tid; i < ntok; i += 512) keys[i] = __float_as_uint(AFF[(size_t)(rowbase + i) * 16 + e]);
        __syncthreads();
        unsigned prefix = 0u, rem = (unsigned)cap;
#pragma unroll 1
        for (int rd = 0; rd < 4; ++rd) {
            const int shift = 24 - 8 * rd; const unsigned himask = rd ? (0xffffffffu << (shift + 8)) : 0u;
            for (int i = c.tid; i < 2048; i += 512) hist[i] = 0u;
            __syncthreads();
            for (int i = c.tid; i < ntok; i += 512) { const unsigned k = keys[i]; if ((k & himask) == prefix) atomicAdd((unsigned*)(hist + c.wave * 256 + ((k >> shift) & 255u)), 1u); }
            __syncthreads();
            if (c.tid < 256) { unsigned t = 0u;
#pragma unroll
                for (int w = 0; w < 8; ++w) t += hist[w * 256 + c.tid];
                tot[c.tid] = t; }
            __syncthreads();
            if (c.wave == 0) { const unsigned t0 = tot[4 * c.lane], t1 = tot[4 * c.lane + 1], t2 = tot[4 * c.lane + 2], t3 = tot[4 * c.lane + 3];
                const unsigned incl = wave_incl_scan_u(t0 + t1 + t2 + t3, c.lane); const unsigned total = (unsigned)__builtin_amdgcn_readlane((int)incl, 63);
                const unsigned ab3 = total - incl, ab2 = ab3 + t3, ab1 = ab2 + t2, ab0 = ab1 + t1;
                if (ab3 < rem && rem <= ab3 + t3) { res[0] = 4 * c.lane + 3; res[1] = ab3; }
                if (ab2 < rem && rem <= ab2 + t2) { res[0] = 4 * c.lane + 2; res[1] = ab2; }
                if (ab1 < rem && rem <= ab1 + t1) { res[0] = 4 * c.lane + 1; res[1] = ab1; }
                if (ab0 < rem && rem <= ab0 + t0) { res[0] = 4 * c.lane; res[1] = ab0; } }
            __syncthreads();
            prefix |= res[0] << shift; rem -= res[1];
        }
        const unsigned ngt = (unsigned)cap - rem, need = rem;
        unsigned mycnt = 0;
        if (c.tid * per < ntok) for (int j = 0; j < per; ++j) { const unsigned k = keys[c.tid * per + j]; mycnt += (k > prefix) ? 1u : 0u; mycnt += (k == prefix) ? 0x10000u : 0u; }
        const unsigned incl = wave_incl_scan_u(mycnt, c.lane);
        if (c.lane == 63) wtot[c.wave] = incl;
        __syncthreads();
        unsigned base = 0;
#pragma unroll
        for (int w = 0; w < 8; ++w) base += (w < c.wave) ? wtot[w] : 0u;
        unsigned excl = base + incl - mycnt; unsigned pg = excl & 0xffffu, pe = excl >> 16;
        if (c.tid * per < ntok) for (int j = 0; j < per; ++j) { const int i = c.tid * per + j; const unsigned k = keys[i]; int slot = -1;
            if (k > prefix) slot = (int)pg++; else if (k == prefix) { if (pe < need) slot = (int)(ngt + pe); ++pe; }
            if (slot >= 0) { ((int*)(c.ws + WS_IDX))[xs0 + slot] = rowbase + i; GV[xs0 + slot] = __uint_as_float(k); ((int*)(c.ws + WS_SEL))[(size_t)(rowbase + i) * 16 + e] = xs0 + slot; } }
        __syncthreads();
        __syncthreads();
    }
}
typedef short bf16x8_t __attribute__((ext_vector_type(8)));
typedef short s16x4_t __attribute__((ext_vector_type(4)));
typedef float f32x16_t __attribute__((ext_vector_type(16)));
__device__ __forceinline__ int crow(int r, int hi) { return (r & 3) + 8 * (r >> 2) + 4 * hi; }
__device__ __forceinline__ float max3f(float a, float b, float c) { float r; asm("v_max3_f32 %0, %1, %2, %3" : "=v"(r) : "v"(a), "v"(b), "v"(c)); return r; }
#define MAX32(P0, P1) fmaxf(max3f(max3f(max3f(max3f(max3f(max3f(max3f(fmaxf(P0[0], P1[0]), P0[1], P1[1]), P0[2], P1[2]), P0[3], P1[3]), P0[4], P1[4]), P0[5], P1[5]), P0[6], P1[6]), P0[7], P1[7]), \
                            max3f(max3f(max3f(max3f(max3f(max3f(max3f(fmaxf(P0[8], P1[8]), P0[9], P1[9]), P0[10], P1[10]), P0[11], P1[11]), P0[12], P1[12]), P0[13], P1[13]), P0[14], P1[14]), P0[15], P1[15]))
__device__ __forceinline__ s16x4_t vtr16(const LAS unsigned char* p) { return __builtin_bit_cast(s16x4_t, __builtin_amdgcn_ds_read_tr16_b64_v4i16((LAS s16x4_t*)p)); }
__device__ __forceinline__ float half_swap_max(float m) { auto rr = __builtin_amdgcn_permlane32_swap(__float_as_uint(m), __float_as_uint(m), false, false); return fmaxf(__uint_as_float(rr[0]), __uint_as_float(rr[1])); }
__device__ __forceinline__ float half_swap_sum(float m) { auto rr = __builtin_amdgcn_permlane32_swap(__float_as_uint(m), __float_as_uint(m), false, false); return __uint_as_float(rr[0]) + __uint_as_float(rr[1]); }

#define MLA_TILE(kbuf, vbuf, first) do { \
    f32x16_t p0 = {}, p1 = {}; \
    const LAS unsigned char* kb = (kbuf) + hi * 1024 + r32 * 16; \
    _Pragma("unroll") for (int d0 = 0; d0 < 6; ++d0) { const bf16x8_t b0 = *(const LAS bf16x8_t*)(kb + d0 * 2048), b1 = *(const LAS bf16x8_t*)(kb + d0 * 2048 + 512); \
        p0 = __builtin_amdgcn_mfma_f32_32x32x16_bf16(b0, qr[d0], p0, 0, 0, 0); p1 = __builtin_amdgcn_mfma_f32_32x32x16_bf16(b1, qr[d0], p1, 0, 0, 0); } \
    float mx = fmaxf(p0[0], p1[0]); \
    _Pragma("unroll") for (int r = 1; r < 16; ++r) mx = fmaxf(mx, fmaxf(p0[r], p1[r])); \
    mx = half_swap_max(mx); \
    if (first) mref = mx; \
    else if (__any(mx > mref + 8.f)) { \
        const float dl = fmaxf(mx - mref, 0.f); mref += dl; const float f = __builtin_amdgcn_exp2f(-dl); l *= f; \
        if (hi == 0) wsf[r32] = f; \
        LDS_WAIT(); \
        _Pragma("unroll") for (int r = 0; r < 16; ++r) { const float fr = wsf[crow(r, hi)]; o0[r] *= fr; o1[r] *= fr; } \
        LDS_WAIT(); } \
    float sacc = 0.f; \
    _Pragma("unroll") for (int r = 0; r < 16; ++r) { p0[r] = __builtin_amdgcn_exp2f(p0[r] - mref); p1[r] = __builtin_amdgcn_exp2f(p1[r] - mref); sacc += p0[r] + p1[r]; } \
    l += sacc; \
    v4u pw[4]; \
    pw[0] = (v4u){cvtpk(p0[0], p0[1]), cvtpk(p0[2], p0[3]), cvtpk(p0[4], p0[5]), cvtpk(p0[6], p0[7])}; \
    pw[1] = (v4u){cvtpk(p0[8], p0[9]), cvtpk(p0[10], p0[11]), cvtpk(p0[12], p0[13]), cvtpk(p0[14], p0[15])}; \
    pw[2] = (v4u){cvtpk(p1[0], p1[1]), cvtpk(p1[2], p1[3]), cvtpk(p1[4], p1[5]), cvtpk(p1[6], p1[7])}; \
    pw[3] = (v4u){cvtpk(p1[8], p1[9]), cvtpk(p1[10], p1[11]), cvtpk(p1[12], p1[13]), cvtpk(p1[14], p1[15])}; \
    const LAS unsigned char* vp = (vbuf) + ((lane >> 4) & 1) * 32 + (lane & 3) * 8 + (4 * hi + ((lane & 15) >> 2)) * 64; \
    _Pragma("unroll") for (int ks = 0; ks < 4; ++ks) { \
        const s16x4_t a0 = vtr16(vp + ks * 1024), a1 = vtr16(vp + ks * 1024 + 512), b0 = vtr16(vp + 4096 + ks * 1024), b1 = vtr16(vp + 4096 + ks * 1024 + 512); \
        const bf16x8_t va = (bf16x8_t){a0[0], a0[1], a0[2], a0[3], a1[0], a1[1], a1[2], a1[3]}, vb = (bf16x8_t){b0[0], b0[1], b0[2], b0[3], b1[0], b1[1], b1[2], b1[3]}; \
        const bf16x8_t pa = __builtin_bit_cast(bf16x8_t, pw[ks]); \
        o0 = __builtin_amdgcn_mfma_f32_32x32x16_bf16(pa, va, o0, 0, 0, 0); o1 = __builtin_amdgcn_mfma_f32_32x32x16_bf16(pa, vb, o1, 0, 0, 0); } \
  } while (0)

__device__ __forceinline__ void ph_attn_mla(const Ctx& c, bool with_ctx) {
    const bf16* QM = (const bf16*)(c.ws + WS_QM); const bf16* KM = (const bf16*)(c.ws + WS_KM); const bf16* VM = (const bf16*)(c.ws + WS_VM); bf16* MIX = (bf16*)(c.ws + WS_MIX);
    const int tid = c.tid, lane = c.lane, r32 = lane & 31, hi = lane >> 5, wid = c.wave;
    LAS unsigned char* ring = c.lds;
    LAS float* wsf = (LAS float*)(c.lds + 81920) + wid * 128;
    const int vcu = (blockIdx.x & 7) * (c.G >> 3) + (blockIdx.x >> 3);
    const int nunits = 768 + (with_ctx ? 48 : 0);
#pragma unroll 1
    for (int L = vcu; L < nunits; L += c.G) {
        int bh, q0, t0, np;
        if (L < 768) { bh = L >> 4; q0 = (L & 15) * 256; t0 = 0; np = NKT / 2; } else { bh = L - 768; q0 = T; t0 = 64; np = 2; }
        const bf16* qp = QM + ((size_t)bh * NQK + q0 + wid * 32 + r32) * 96 + hi * 8;
        bf16x8_t qr[6];
#pragma unroll
        for (int d0 = 0; d0 < 6; ++d0) qr[d0] = *(const bf16x8_t*)(qp + d0 * 16);
        const unsigned char* kt = (const unsigned char*)(KM + (size_t)(bh * NKT + t0) * 6144);
        const unsigned char* vt = (const unsigned char*)(VM + (size_t)(bh * NKT + t0) * 4096);
        const unsigned char* sp[5]; size_t sst[5];
#pragma unroll
        for (int k = 0; k < 5; ++k) { const int pc = tid + 512 * k; const bool isk = pc < 1536; sp[k] = isk ? kt + pc * 16 : vt + (pc - 1536) * 16; sst[k] = isk ? 24576 : 16384; }
        v4u rr[5];
#pragma unroll
        for (int k = 0; k < 5; ++k) rr[k] = *(const v4u*)sp[k];
        float mref = 0.f, l = 0.f; f32x16_t o0 = {}, o1 = {};
#pragma unroll 1
        for (int it = 0; it < np; ++it) {
            LAS unsigned char* buf = ring + (it & 1) * 40960;
#pragma unroll
            for (int k = 0; k < 5; ++k) *(LAS v4u*)(buf + (tid + 512 * k) * 16) = rr[k];
            __syncthreads();
            if (it + 1 < np) {
#pragma unroll
                for (int k = 0; k < 5; ++k) rr[k] = *(const v4u*)(sp[k] + (size_t)(it + 1) * sst[k]); }
            MLA_TILE(buf, buf + 24576, it == 0);
            MLA_TILE(buf + 12288, buf + 24576 + 8192, false);
        }
        l = half_swap_sum(l);
        if (hi == 0) wsf[32 + r32] = l;
        LDS_WAIT();
        const int b = bh / 6, h = bh - b * 6;
        const int rowbase = (L < 768 ? b * T + q0 : MLAT + b * NC) + wid * 32;
#pragma unroll
        for (int r = 0; r < 16; ++r) { const int qq = crow(r, hi); const float rl = __builtin_amdgcn_rcpf(wsf[32 + qq]); bf16* op = MIX + (size_t)(rowbase + qq) * 1024 + 256 + h * 64 + r32;
            op[0] = (bf16)f2bf(o0[r] * rl); op[32] = (bf16)f2bf(o1[r] * rl); }
        LDS_WAIT();
        __syncthreads();
    }
}

#define SBAR0() __builtin_amdgcn_sched_barrier(0)
#define KFRAG(base, g) (*(const LAS bf16x8_t*)((base) + ((g) >> 1) * 2048 + ((g) & 1) * 512))
#define VLO(base, g) vtr16((base) + ((g) & 1) * 4096 + ((g) >> 1) * 1024)
#define VHI(base, g) vtr16((base) + ((g) & 1) * 4096 + ((g) >> 1) * 1024 + 512)
#define PACK4(P, B) (v4u){cvtpk(P[B], P[B + 1]), cvtpk(P[B + 2], P[B + 3]), cvtpk(P[B + 4], P[B + 5]), cvtpk(P[B + 6], P[B + 7])}
#define EXP4(P, B) do { _Pragma("unroll") for (int e_ = 0; e_ < 4; ++e_) { P[(B) + e_] = __builtin_amdgcn_exp2f(P[(B) + e_] - mref); sacc += P[(B) + e_]; } } while (0)
#define VF8(g) (bf16x8_t){vl[(g) & 3][0], vl[(g) & 3][1], vl[(g) & 3][2], vl[(g) & 3][3], vh[(g) & 3][0], vh[(g) & 3][1], vh[(g) & 3][2], vh[(g) & 3][3]}
#define RESCALE(mxv) do { const float dl_ = fmaxf((mxv) - mref, 0.f); mref += dl_; const float f_ = __builtin_amdgcn_exp2f(-dl_); l *= f_; \
        if (hi == 0) wsf[r32] = f_; LDS_WAIT(); \
        _Pragma("unroll") for (int r = 0; r < 16; ++r) { const float fr_ = wsf[crow(r, hi)]; o0[r] *= fr_; o1[r] *= fr_; } LDS_WAIT(); } while (0)
__device__ __forceinline__ void ph_attn_mla2(const Ctx& c, bool with_ctx) {
    const bf16* QM = (const bf16*)(c.ws + WS_QM); const bf16* KM = (const bf16*)(c.ws + WS_KM); const bf16* VM = (const bf16*)(c.ws + WS_VM); bf16* MIX = (bf16*)(c.ws + WS_MIX);
    const int tid = c.tid, lane = c.lane, r32 = lane & 31, hi = lane >> 5, wid = c.wave;
    LAS unsigned char* ring = c.lds;
    LAS float* wsf = (LAS float*)(c.lds + 81920) + wid * 128;
    const int vcu = (blockIdx.x & 7) * (c.G >> 3) + (blockIdx.x >> 3);
    const int cxu = (c.G == 256) ? (((int)(blockIdx.x >> 3) >= 26) ? (int)(blockIdx.x & 7) * 6 + (int)(blockIdx.x >> 3) - 26 : -1) : (vcu < 48 ? vcu : -1);
    const int nunits = 768 + (with_ctx ? 48 : 0);
    const int nmine = c.G == 256 ? 3 + ((with_ctx && cxu >= 0) ? 1 : 0) : (vcu < nunits ? (nunits - vcu + c.G - 1) / c.G : 0);
    const int koff = hi * 1024 + r32 * 16, voff = ((lane >> 4) & 1) * 32 + (lane & 3) * 8 + (4 * hi + ((lane & 15) >> 2)) * 64;
#pragma unroll 1
    for (int ui = 0; ui < nmine; ++ui) {
        const int L = (c.G != 256 || ui < 3) ? vcu + ui * c.G : 768 + cxu;
        int bh, q0, t0, np;
        if (L < 768) { bh = L >> 4; q0 = (L & 15) * 256; t0 = 0; np = NKT / 2; } else { bh = L - 768; q0 = T; t0 = 64; np = 2; }
        const bf16* qp = QM + ((size_t)bh * NQK + q0 + wid * 32 + r32) * 96 + hi * 8;
        bf16x8_t qr[6];
#pragma unroll
        for (int d0 = 0; d0 < 6; ++d0) qr[d0] = *(const bf16x8_t*)(qp + d0 * 16);
        const unsigned char* kt = (const unsigned char*)(KM + (size_t)(bh * NKT + t0) * 6144);
        const unsigned char* vt = (const unsigned char*)(VM + (size_t)(bh * NKT + t0) * 4096);
#define MLA_DMA(itn, slot) do { _Pragma("unroll") for (int k_ = 0; k_ < 5; ++k_) { const int pc_ = wid + 8 * k_; \
            const unsigned char* src_ = (pc_ < 24 ? kt + (size_t)(itn) * 24576 + pc_ * 1024 : vt + (size_t)(itn) * 16384 + (pc_ - 24) * 1024) + lane * 16; \
            __builtin_amdgcn_global_load_lds((const unsigned*)src_, (LAS unsigned*)(ring + (slot) * 40960 + pc_ * 1024), 16, 0, 0); } } while (0)
        MLA_DMA(0, 0);
        float mref = 0.f, l = 0.f; f32x16_t o0 = {}, o1 = {};
#pragma unroll 1
        for (int it = 0; it < np; ++it) {
            LAS unsigned char* buf = ring + (it & 1) * 40960;
            asm volatile("s_waitcnt vmcnt(0)" ::: "memory");
            __syncthreads();
            if (it + 1 < np) MLA_DMA(it + 1, (it + 1) & 1);
            const LAS unsigned char* ka = buf + koff; const LAS unsigned char* kb = buf + 12288 + koff;
            const LAS unsigned char* va = buf + 24576 + voff; const LAS unsigned char* vb = buf + 32768 + voff;
            bf16x8_t kf[6]; s16x4_t vl[4], vh[4];
#pragma unroll
            for (int g = 0; g < 6; ++g) kf[g] = KFRAG(ka, g);
            f32x16_t pa0 = {}, pa1 = {};
#pragma unroll
            for (int g = 0; g < 12; ++g) {
                if (g & 1) pa1 = __builtin_amdgcn_mfma_f32_32x32x16_bf16(kf[g % 6], qr[g >> 1], pa1, 0, 0, 0); else pa0 = __builtin_amdgcn_mfma_f32_32x32x16_bf16(kf[g % 6], qr[g >> 1], pa0, 0, 0, 0);
                if (g < 6) kf[g % 6] = KFRAG(ka, g + 6); else kf[g % 6] = KFRAG(kb, g - 6);
                SBAR0(); }
            float mx = MAX32(pa0, pa1);
            mx = half_swap_max(mx);
            if (it == 0) mref = mx; else if (__any(mx > mref + 8.f)) RESCALE(mx);
            f32x16_t pb0 = {}, pb1 = {}; float sacc = 0.f; v4u pwa[4];
            SBAR0();
#pragma unroll
            for (int g = 0; g < 12; ++g) {
                if (g & 1) pb1 = __builtin_amdgcn_mfma_f32_32x32x16_bf16(kf[g % 6], qr[g >> 1], pb1, 0, 0, 0); else pb0 = __builtin_amdgcn_mfma_f32_32x32x16_bf16(kf[g % 6], qr[g >> 1], pb0, 0, 0, 0);
                if (g < 6) kf[g % 6] = KFRAG(kb, g + 6);
                if (g >= 8) { vl[g - 8] = VLO(va, g - 8); vh[g - 8] = VHI(va, g - 8); }
                if (g < 4) EXP4(pa0, 4 * g); else if (g < 8) EXP4(pa1, 4 * (g - 4));
                else if (g == 8) pwa[0] = PACK4(pa0, 0); else if (g == 9) pwa[1] = PACK4(pa0, 8); else if (g == 10) pwa[2] = PACK4(pa1, 0); else pwa[3] = PACK4(pa1, 8);
                SBAR0(); }
            l += sacc;
            float mxb = MAX32(pb0, pb1);
            mxb = half_swap_max(mxb);
            const bool rescb = __any(mxb > mref + 8.f);
            sacc = 0.f; v4u pwb[4];
            SBAR0();
#pragma unroll
            for (int g = 0; g < 8; ++g) {
                const bf16x8_t vf = VF8(g); const bf16x8_t pf = __builtin_bit_cast(bf16x8_t, pwa[g >> 1]);
                if (g & 1) o1 = __builtin_amdgcn_mfma_f32_32x32x16_bf16(pf, vf, o1, 0, 0, 0); else o0 = __builtin_amdgcn_mfma_f32_32x32x16_bf16(pf, vf, o0, 0, 0, 0);
                if (g < 4) { vl[g & 3] = VLO(va, g + 4); vh[g & 3] = VHI(va, g + 4); } else { vl[g & 3] = VLO(vb, g - 4); vh[g & 3] = VHI(vb, g - 4); }
                if (!rescb) { if (g < 4) EXP4(pb0, 4 * g); else EXP4(pb1, 4 * (g - 4));
                    if (g == 1) pwb[0] = PACK4(pb0, 0); else if (g == 3) pwb[1] = PACK4(pb0, 8); else if (g == 5) pwb[2] = PACK4(pb1, 0); else if (g == 7) pwb[3] = PACK4(pb1, 8); }
                SBAR0(); }
            if (rescb) { RESCALE(mxb);
#pragma unroll
                for (int g = 0; g < 4; ++g) { EXP4(pb0, 4 * g); EXP4(pb1, 4 * g); }
                pwb[0] = PACK4(pb0, 0); pwb[1] = PACK4(pb0, 8); pwb[2] = PACK4(pb1, 0); pwb[3] = PACK4(pb1, 8); }
            l += sacc;
#pragma unroll
            for (int g = 0; g < 8; ++g) {
                const bf16x8_t vf = VF8(g); const bf16x8_t pf = __builtin_bit_cast(bf16x8_t, pwb[g >> 1]);
                if (g & 1) o1 = __builtin_amdgcn_mfma_f32_32x32x16_bf16(pf, vf, o1, 0, 0, 0); else o0 = __builtin_amdgcn_mfma_f32_32x32x16_bf16(pf, vf, o0, 0, 0, 0);
                if (g < 4) { vl[g & 3] = VLO(vb, g + 4); vh[g & 3] = VHI(vb, g + 4); }
                SBAR0(); }
        }
        l = half_swap_sum(l);
        if (hi == 0) wsf[32 + r32] = l;
        LDS_WAIT();
        const int b = bh / 6, h = bh - b * 6;
        const int rowbase = (L < 768 ? b * T + q0 : MLAT + b * NC) + wid * 32;
#pragma unroll
        for (int r = 0; r < 16; ++r) { const int qq = crow(r, hi); const float rl = __builtin_amdgcn_rcpf(wsf[32 + qq]); bf16* op = MIX + (size_t)(rowbase + qq) * 1024 + 256 + h * 64 + r32;
            op[0] = (bf16)f2bf(o0[r] * rl); op[32] = (bf16)f2bf(o1[r] * rl); }
        LDS_WAIT();
        __syncthreads();
    }
}
__device__ __forceinline__ void ph_attn_na(KA p, const Ctx& c, int layer, bool with_ctx) {
    const bf16* P = (const bf16*)(c.ws + WS_P); bf16* MIX = (bf16*)(c.ws + WS_MIX);
    const int tid = c.tid, lane = c.lane, r32 = lane & 31, hi = lane >> 5, wid = c.wave;
    LAS unsigned char* ring = c.lds;
    LAS float* wsf = (LAS float*)(c.lds + 32768) + wid * 128;
    LAS float* rpbL = (LAS float*)(c.lds + 32768 + 4096);
    const int vcu = (blockIdx.x & 7) * (c.G >> 3) + (blockIdx.x >> 3);
    const int skv = tid >> 3, sch = tid & 7;
    constexpr int HG_WAVES = 6;
    const int n2 = 32 * (NKT - (with_ctx ? 0 : 4)) - c.G * HG_WAVES;
    int ustart = vcu, ucount = 3, ustride = c.G;
    if (c.G == 256) { const int x = blockIdx.x & 7, j = blockIdx.x >> 3;
        int nA = 0; for (int jj = 0; jj < 32; ++jj) nA += ((8 * jj + x) * HG_WAVES < n2) ? 1 : 0;
        const int nB = 32 - nA, k4 = 96 - 2 * nA - 3 * nB;
        if (k4 >= 0 && k4 <= nB) { ustride = 1;
            if (j < nA) { ustart = 96 * x + 2 * j; ucount = 2; }
            else { const int jb = j - nA; ustart = 96 * x + 2 * nA + (jb < k4 ? 4 * jb : 4 * k4 + 3 * (jb - k4)); ucount = jb < k4 ? 4 : 3; } } }
    const int cxu = (c.G == 256) ? (((int)(blockIdx.x >> 3) >= 26) ? (int)(blockIdx.x & 7) * 6 + (int)(blockIdx.x >> 3) - 26 : -1) : (vcu < 48 ? vcu : -1);
    const int nunits = 768 + (with_ctx ? 48 : 0);
    const int nlat = ustride == 1 ? ucount : 3, nmine = c.G == 256 ? nlat + ((with_ctx && cxu >= 0) ? 1 : 0) : (vcu < nunits ? (nunits - vcu + c.G - 1) / c.G : 0);
#pragma unroll 1
    for (int ui = 0; ui < nmine; ++ui) {
        const int L = (c.G != 256 || ui < nlat) ? ustart + ui * ustride : 768 + cxu;
        const bool lat = L < 768; const int bh = lat ? (L >> 4) : (L - 768), b = bh / 6, h = bh - b * 6, r0 = lat ? (L & 15) * 4 : 0;
        const int krlo = min(max(r0 - 4, 0), 56), nkr = lat ? (min(max(r0 + 3 - 4, 0), 56) + 8 - krlo) : 0, ntile = nkr + 4;
        const int rq = r0 + (wid >> 1), cq = 32 * (wid & 1) + r32, rsq = min(max(rq - 4, 0), 56), cs = min(max(cq - 8, 0), 48);
        { const float* rp = p->in[15] + ((size_t)layer * 6 + h) * 465; for (int i = tid; i < 465; i += 512) rpbL[i] = rp[i] * LOG2E; }
        const int qrow = lat ? b * T + rq * 64 + cq : MLAT + b * NC + wid * 32 + r32;
        bf16x8_t qr[4];
#pragma unroll
        for (int d0 = 0; d0 < 4; ++d0) qr[d0] = *(const bf16x8_t*)(P + (size_t)qrow * NP + NA_Q + h * 64 + d0 * 16 + hi * 8);
        const size_t hoff = (size_t)h * 64 + sch * 8;
#define NA_TOK(it) ((it) < nkr ? b * T + (krlo + (it)) * 64 + skv : MLAT + b * NC + ((it) - nkr) * 64 + skv)
#define NA_DMA(it, slot) do { const int t_ = (it); \
            const int tk_ = t_ < nkr ? b * T + (krlo + t_) * 64 + lane : MLAT + b * NC + (t_ - nkr) * 64 + lane; \
            const int tv_ = t_ < nkr ? b * T + (krlo + t_) * 64 + 16 * (wid & 3) + (lane >> 2) : MLAT + b * NC + (t_ - nkr) * 64 + 16 * (wid & 3) + (lane >> 2); \
            __builtin_amdgcn_global_load_lds((const unsigned*)(P + (size_t)tk_ * NP + NA_K + h * 64 + wid * 8), (LAS unsigned*)(ring + (slot) * 16384 + wid * 1024), 16, 0, 0); \
            __builtin_amdgcn_global_load_lds((const unsigned*)(P + (size_t)tv_ * NP + NA_V + h * 64 + (wid >> 2) * 32 + (lane & 3) * 8), (LAS unsigned*)(ring + (slot) * 16384 + 8192 + wid * 1024), 16, 0, 0); } while (0)
        NA_DMA(0, 0);
        float mref = 0.f, l = 0.f; f32x16_t o0 = {}, o1 = {}; bool started = false;
#pragma unroll 1
        for (int it = 0; it < ntile; ++it) {
            LAS unsigned char* buf = ring + (it & 1) * 16384;
            asm volatile("s_waitcnt vmcnt(0)" ::: "memory");
            __syncthreads();
            if (it + 1 < ntile) NA_DMA(it + 1, (it + 1) & 1);
            const bool win = it < nkr; const int kr = krlo + it;
            if (win && (kr < rsq || kr > rsq + 7)) continue;
#define NA_TILE(WIN, A0, A1, B0, B1, KS0, KS1) do { \
            f32x16_t p0 = {}, p1 = {}; \
            const LAS unsigned char* kb = buf + hi * 1024 + r32 * 16; \
            _Pragma("unroll") for (int d0 = 0; d0 < 4; ++d0) { const bf16x8_t b0 = *(const LAS bf16x8_t*)(kb + d0 * 2048), b1 = *(const LAS bf16x8_t*)(kb + d0 * 2048 + 512); \
                p0 = __builtin_amdgcn_mfma_f32_32x32x16_bf16(b0, qr[d0], p0, 0, 0, 0); p1 = __builtin_amdgcn_mfma_f32_32x32x16_bf16(b1, qr[d0], p1, 0, 0, 0); } \
            if (WIN) { const LAS float* bp = rpbL + (kr - rq + 7) * 31 + 15 - cq; \
                _Pragma("unroll") for (int r = A0; r < A1; ++r) { const int k0 = crow(r, hi); p0[r] = (k0 >= cs && k0 < cs + 16) ? p0[r] * NA_QS + bp[k0] : -INFINITY; } \
                _Pragma("unroll") for (int r = B0; r < B1; ++r) { const int k1 = 32 + crow(r, hi); p1[r] = (k1 >= cs && k1 < cs + 16) ? p1[r] * NA_QS + bp[k1] : -INFINITY; } } \
            else { _Pragma("unroll") for (int r = 0; r < 16; ++r) { p0[r] *= NA_QS; p1[r] *= NA_QS; } } \
            float mx = -INFINITY; \
            _Pragma("unroll") for (int r = A0; r < A1; ++r) mx = fmaxf(mx, p0[r]); \
            _Pragma("unroll") for (int r = B0; r < B1; ++r) mx = fmaxf(mx, p1[r]); \
            mx = half_swap_max(mx); \
            if (!started) { mref = mx; started = true; } \
            else if (__any(mx > mref + 8.f)) { \
                const float dl = fmaxf(mx - mref, 0.f); mref += dl; const float f = __builtin_amdgcn_exp2f(-dl); l *= f; \
                if (hi == 0) wsf[r32] = f; \
                LDS_WAIT(); \
                _Pragma("unroll") for (int r = 0; r < 16; ++r) { const float fr = wsf[crow(r, hi)]; o0[r] *= fr; o1[r] *= fr; } \
                LDS_WAIT(); \
            } \
            float sacc = 0.f; \
            _Pragma("unroll") for (int r = 0; r < 16; ++r) { if (r >= A0 && r < A1) { p0[r] = __builtin_amdgcn_exp2f(p0[r] - mref); sacc += p0[r]; } else p0[r] = 0.f; \
                                                             if (r >= B0 && r < B1) { p1[r] = __builtin_amdgcn_exp2f(p1[r] - mref); sacc += p1[r]; } else p1[r] = 0.f; } \
            l += sacc; \
            v4u pw[4]; \
            pw[0] = (v4u){cvtpk(p0[0], p0[1]), cvtpk(p0[2], p0[3]), cvtpk(p0[4], p0[5]), cvtpk(p0[6], p0[7])}; \
            pw[1] = (v4u){cvtpk(p0[8], p0[9]), cvtpk(p0[10], p0[11]), cvtpk(p0[12], p0[13]), cvtpk(p0[14], p0[15])}; \
            pw[2] = (v4u){cvtpk(p1[0], p1[1]), cvtpk(p1[2], p1[3]), cvtpk(p1[4], p1[5]), cvtpk(p1[6], p1[7])}; \
            pw[3] = (v4u){cvtpk(p1[8], p1[9]), cvtpk(p1[10], p1[11]), cvtpk(p1[12], p1[13]), cvtpk(p1[14], p1[15])}; \
            const LAS unsigned char* vp = buf + 8192 + ((lane >> 4) & 1) * 32 + (lane & 3) * 8 + (4 * hi + ((lane & 15) >> 2)) * 64; \
            _Pragma("unroll") for (int ks = KS0; ks < KS1; ++ks) { \
                const s16x4_t a0 = vtr16(vp + ks * 1024), a1 = vtr16(vp + ks * 1024 + 512), b0 = vtr16(vp + 4096 + ks * 1024), b1 = vtr16(vp + 4096 + ks * 1024 + 512); \
                const bf16x8_t va = (bf16x8_t){a0[0], a0[1], a0[2], a0[3], a1[0], a1[1], a1[2], a1[3]}, vb = (bf16x8_t){b0[0], b0[1], b0[2], b0[3], b1[0], b1[1], b1[2], b1[3]}; \
                const bf16x8_t pa = __builtin_bit_cast(bf16x8_t, pw[ks]); \
                o0 = __builtin_amdgcn_mfma_f32_32x32x16_bf16(pa, va, o0, 0, 0, 0); o1 = __builtin_amdgcn_mfma_f32_32x32x16_bf16(pa, vb, o1, 0, 0, 0); } } while (0)
            if (!win) NA_TILE(false, 0, 16, 0, 16, 0, 4);
            else if ((wid & 1) == 0) NA_TILE(true, 0, 16, 0, 4, 0, 3);
            else NA_TILE(true, 12, 16, 0, 16, 1, 4);
#undef NA_TILE
        }
#undef NA_TOK
        l = half_swap_sum(l);
        if (hi == 0) wsf[32 + r32] = l;
        LDS_WAIT();
        const int rowbase = lat ? b * T + rq * 64 + 32 * (wid & 1) : MLAT + b * NC + wid * 32;
#pragma unroll
        for (int r = 0; r < 16; ++r) { const int qq = crow(r, hi); const float rl = __builtin_amdgcn_rcpf(wsf[32 + qq]); bf16* op = MIX + (size_t)(rowbase + qq) * 1024 + 640 + h * 64 + r32;
            op[0] = (bf16)f2bf(o0[r] * rl); op[32] = (bf16)f2bf(o1[r] * rl); }
        LDS_WAIT();
        __syncthreads();
    }
}
constexpr int HG_BP = 68, HG_BL_BYTES = 65 * HG_BP * 4, HG_WAVE_BYTES = HG_BL_BYTES + 8192, HG_WAVES = 6;
constexpr int HG1_WAVES = 4;
static_assert(HG_WAVES == 6, "the neighbourhood-attention unit deal assumes six HGRN waves per workgroup");
__device__ __forceinline__ float exp_c(float x) { return __builtin_amdgcn_exp2f(fminf(x, 115.f)); }
__device__ __forceinline__ unsigned pk_bf(float a, float b) { return cvtpk(a, b); }
__device__ __forceinline__ f32x2 ex2(f32x2 x) { return (f32x2){__builtin_amdgcn_exp2f(x.x), __builtin_amdgcn_exp2f(x.y)}; }
__device__ __forceinline__ f32x2 mn2(f32x2 x, float c) { return (f32x2){fminf(x.x, c), fminf(x.y, c)}; }
__device__ __forceinline__ unsigned pk_bf2(f32x2 v) { return cvtpk(v.x, v.y); }
__device__ __forceinline__ unsigned kt2(f32x2 bj, f32x2 bp, f32x2 r) { return pk_bf2(((f32x2){1.f, 1.f} - ex2(bj - bp)) * ex2(mn2(r - bj, 115.f))); }
__device__ __forceinline__ unsigned qt2(unsigned qpair, f32x2 bi, f32x2 r3) { return pk_bf2((f32x2){bf2f(qpair & 0xffffu), bf2f(qpair >> 16)} * ex2(mn2(bi - r3, 112.f))); }
__device__ __forceinline__ float sigm_fast(float z) { return __builtin_amdgcn_rcpf(1.f + __builtin_amdgcn_exp2f(-z * LOG2E)); }

#define HG_LOAD_V(vr, row0) _Pragma("unroll") for (int k_ = 0; k_ < 8; ++k_) { const int idx_ = lane_l + 64 * k_; vr[k_] = *(const v4u*)(P + (size_t)((row0) + (idx_ >> 3)) * NP + HG_I + h * 64 + (idx_ & 7) * 8); }
#define HG_STORE_V(vr) _Pragma("unroll") for (int k_ = 0; k_ < 8; ++k_) { const int idx_ = lane_l + 64 * k_, tok_ = idx_ >> 3, ch_ = idx_ & 7; *(LAS v4u*)(vimg + (ch_ >> 2) * 4096 + tok_ * 64 + (ch_ & 3) * 16) = vr[k_]; }
__device__ __forceinline__ void hg_zload(const bf16* P, int row0, int dir, int h, int lane, unsigned short (&zr)[64]) {
    const int zcol = (dir ? HG_ZB : HG_ZF) + h * 64 + lane;
    unsigned zb = (unsigned)(row0 * NP + zcol) * 2u; asm volatile("" : "+v"(zb));
    const char* Pb = (const char*)P;
#pragma unroll
    for (int i = 0; i < 64; ++i) { zr[i] = *(const bf16*)(Pb + zb); zb += (unsigned)NP * 2u; }
}
__device__ __forceinline__ void hg_cumsum_z(const unsigned short (&zr)[64], LAS float* bL, int dir, float lbv, int lane) {
    float acc = 0.f;
    if (dir == 0) { bL[lane] = 0.f;
#pragma unroll
        for (int i = 0; i < 64; ++i) { const float f = fmaxf(lbv + (1.f - lbv) * sigm_fast(bf2f(zr[i])), 1e-20f); acc += __builtin_amdgcn_logf(f); bL[(i + 1) * HG_BP + lane] = acc; } }
    else { bL[64 * HG_BP + lane] = 0.f;
#pragma unroll
        for (int i = 63; i >= 0; --i) { const float f = fmaxf(lbv + (1.f - lbv) * sigm_fast(bf2f(zr[i])), 1e-20f); acc += __builtin_amdgcn_logf(f); bL[i * HG_BP + lane] = acc; } }
    LDS_WAIT(); asm volatile("" ::: "memory");
}
__device__ __forceinline__ void hg_cumsum(const bf16* P, LAS float* bL, int row0, int dir, int h, float lbv, int lane) {
    unsigned short zr[64]; hg_zload(P, row0, dir, h, lane, zr); hg_cumsum_z(zr, bL, dir, lbv, lane);
}

__device__ __forceinline__ void ph_hgrn1_mfma(KA p, const Ctx& c, int layer) {
    if (c.wave >= HG1_WAVES) return;
    const bf16* P = (const bf16*)(c.ws + WS_P); float* HU = (float*)(c.ws + WS_HU); float* HD = (float*)(c.ws + WS_HD); const float* LB = (const float*)(c.ws + WS_LB);
    LAS float* bL = (LAS float*)(c.lds + c.wave * HG_WAVE_BYTES); LAS unsigned char* vimg = c.lds + c.wave * HG_WAVE_BYTES + HG_BL_BYTES;
    const int lane = c.lane, r32 = lane & 31, hi = lane >> 5;
#pragma unroll 1
    for (int item = blockIdx.x * HG1_WAVES + c.wave; item < 32 * NKT; item += c.G * HG1_WAVES) {
        const int bh = item / NKT, cnat = item - bh * NKT, h = bh & 3, b = bh >> 2, row0 = hg_row(b, cnat, 0);
        int lane_l = lane; asm volatile("" : "+v"(lane_l));
        v4u vr[8]; HG_LOAD_V(vr, row0);
        unsigned short zf[64], zb2[64]; hg_zload(P, row0, 0, h, lane, zf); hg_zload(P, row0, 1, h, lane, zb2);
        HG_STORE_V(vr);
        const LAS unsigned char* vpn = vimg + ((lane >> 4) & 1) * 32 + (lane & 3) * 8 + (8 * hi + ((lane & 15) >> 2)) * 64;
#pragma unroll 1
        for (int dir = 0; dir < 2; ++dir) {
            const int seq = bh * 2 + dir, s = dir ? (cnat < 4 ? 3 - cnat : 71 - cnat) : cnat;
            if (s >= NHS) continue;
            if (dir == 0) hg_cumsum_z(zf, bL, 0, LB[(0 * DEPTH + layer) * 256 + h * 64 + lane], lane); else hg_cumsum_z(zb2, bL, 1, LB[(1 * DEPTH + layer) * 256 + h * 64 + lane], lane);
            const int rb = 1 - dir, rp = dir, rend = dir ? 0 : 64;
            f32x16_t u[2][2] = {};
            {
                const LAS float* bc = bL + (8 * hi + rb) * HG_BP + r32; const LAS float* bv = bL + (8 * hi + rp) * HG_BP + r32;
                const f32x2 bend2 = {bL[rend * HG_BP + r32], bL[rend * HG_BP + 32 + r32]};
#pragma unroll
                for (int j0 = 0; j0 < 4; ++j0) { float kb0[8], kb1[8];
#pragma unroll
                    for (int jj = 0; jj < 8; ++jj) { const int n = 16 * j0 + jj;
                        const f32x2 cur = {bc[n * HG_BP], bc[n * HG_BP + 32]}, prev = {bv[n * HG_BP], bv[n * HG_BP + 32]};
                        const f32x2 kv = ((f32x2){1.f, 1.f} - ex2(cur - prev)) * ex2(bend2 - cur);
                        kb0[jj] = kv.x; kb1[jj] = kv.y; }
                    const bf16x8_t ka0 = __builtin_bit_cast(bf16x8_t, (v4u){pk_bf(kb0[0], kb0[1]), pk_bf(kb0[2], kb0[3]), pk_bf(kb0[4], kb0[5]), pk_bf(kb0[6], kb0[7])});
                    const bf16x8_t ka1 = __builtin_bit_cast(bf16x8_t, (v4u){pk_bf(kb1[0], kb1[1]), pk_bf(kb1[2], kb1[3]), pk_bf(kb1[4], kb1[5]), pk_bf(kb1[6], kb1[7])});
#pragma unroll
                    for (int eh = 0; eh < 2; ++eh) { const s16x4_t a0 = vtr16(vpn + eh * 4096 + j0 * 1024), a1 = vtr16(vpn + eh * 4096 + j0 * 1024 + 256);
                        const bf16x8_t vb = (bf16x8_t){a0[0], a0[1], a0[2], a0[3], a1[0], a1[1], a1[2], a1[3]};
                        u[0][eh] = __builtin_amdgcn_mfma_f32_32x32x16_bf16(ka0, vb, u[0][eh], 0, 0, 0); u[1][eh] = __builtin_amdgcn_mfma_f32_32x32x16_bf16(ka1, vb, u[1][eh], 0, 0, 0); } } }
            bf16* uo = (bf16*)HU + ((size_t)seq * NKT + s) * 4096;
#pragma unroll
            for (int dh = 0; dh < 2; ++dh)
#pragma unroll
                for (int eh = 0; eh < 2; ++eh)
#pragma unroll
                    for (int g = 0; g < 4; ++g) *(v2u*)(uo + (32 * eh + r32) * 64 + 32 * dh + 8 * g + 4 * hi) = (v2u){pk_bf(u[dh][eh][4 * g], u[dh][eh][4 * g + 1]), pk_bf(u[dh][eh][4 * g + 2], u[dh][eh][4 * g + 3])};
            HD[((size_t)seq * NKT + s) * 64 + lane] = __builtin_amdgcn_exp2f(bL[rend * HG_BP + lane]);
            LDS_WAIT(); asm volatile("" ::: "memory");
        }
    }
}

__device__ __forceinline__ void ph_hgrn_scan_t(const Ctx& c, bool dummy = false) {
    unsigned* HUp = (unsigned*)(c.ws + WS_HU); const float* HD = (const float*)(c.ws + WS_HD); const size_t ooff = dummy ? (size_t)(826 * MiB - WS_HU) / 4 : 0;
    for (int el = blockIdx.x * 512 + c.tid; el < 64 * 2048; el += c.G * 512) {
        const int seq = el >> 11, pr = el & 2047, d = (pr & 31) * 2; float S0 = 0.f, S1 = 0.f;
        unsigned* hu = HUp + (size_t)seq * NKT * 2048 + pr; const float* hd = HD + (size_t)seq * NKT * 64 + d;
#pragma unroll 1
        for (int s0 = 0; s0 < NHS; s0 += 34) {
            unsigned uu[34]; f32x2 dd[34];
#pragma unroll
            for (int i = 0; i < 34; ++i) if (s0 + i < NHS) { uu[i] = hu[(size_t)(s0 + i) * 2048]; dd[i] = *(const f32x2*)(hd + (s0 + i) * 64); }
#pragma unroll
            for (int i = 0; i < 34; ++i) if (s0 + i < NHS) { hu[ooff + (size_t)(s0 + i) * 2048] = pk_bf(S0, S1); S0 = dd[i].x * S0 + bf2f(uu[i] & 0xffffu); S1 = dd[i].y * S1 + bf2f(uu[i] >> 16); }
        }
        hu[ooff + (size_t)NHS * 2048] = pk_bf(S0, S1);
    }
}

__device__ __forceinline__ void ph_hgrn3_mfma(KA p, const Ctx& c, int layer, bool with_ctx) {
    if (c.wave >= HG_WAVES) return;
    const bf16* P = (const bf16*)(c.ws + WS_P); const float* HU = (const float*)(c.ws + WS_HU); const float* LB = (const float*)(c.ws + WS_LB); bf16* MIX = (bf16*)(c.ws + WS_MIX);
    LAS float* bL = (LAS float*)(c.lds + c.wave * HG_WAVE_BYTES); LAS unsigned char* vimg = c.lds + c.wave * HG_WAVE_BYTES + HG_BL_BYTES;
    const int lane = c.lane, r32 = lane & 31, hi = lane >> 5;
    const int c0 = with_ctx ? 0 : 4, nper = NKT - c0;
    const LAS unsigned char* vp = vimg + ((lane >> 4) & 1) * 32 + (lane & 3) * 8 + (4 * hi + ((lane & 15) >> 2)) * 64;
#pragma unroll 1
    for (int item = blockIdx.x * HG_WAVES + c.wave; item < 32 * nper; item += c.G * HG_WAVES) {
        const int bh = item / nper, cnat = c0 + (item - bh * nper), h = bh & 3, b = bh >> 2, row0 = hg_row(b, cnat, 0);
        int lane_l = lane; asm volatile("" : "+v"(lane_l));
        v4u vr[8]; HG_LOAD_V(vr, row0);
        v4u qp0[4], qp1[4];
#pragma unroll
        for (int d0 = 0; d0 < 4; ++d0) { qp0[d0] = *(const v4u*)(P + (size_t)(row0 + r32) * NP + HG_Q + h * 64 + 16 * d0 + 8 * hi); qp1[d0] = *(const v4u*)(P + (size_t)(row0 + 32 + r32) * NP + HG_Q + h * 64 + 16 * d0 + 8 * hi); }
        HG_STORE_V(vr);
        f32x16_t o00 = {}, o01 = {}, o10 = {}, o11 = {};
#pragma unroll 1
        for (int dir = 0; dir < 2; ++dir) {
            const int seq = bh * 2 + dir, s = dir ? (cnat < 4 ? 3 - cnat : 71 - cnat) : cnat;
            const bf16* S0 = (const bf16*)HU + ((size_t)seq * NKT + s) * 4096;
            bf16x8_t sfr[4][2];
#pragma unroll
            for (int d0 = 0; d0 < 4; ++d0)
#pragma unroll
                for (int eh = 0; eh < 2; ++eh) sfr[d0][eh] = *(const bf16x8_t*)(S0 + (32 * eh + r32) * 64 + 16 * d0 + 8 * hi);
            hg_cumsum(P, bL, row0, dir, h, LB[(dir * DEPTH + layer) * 256 + h * 64 + lane], lane);
            const int rb = 1 - dir, rp = dir;
#pragma unroll 1
            for (int I = 0; I < 2; ++I) {
                const int ti = 32 * I + r32;
#pragma unroll
                for (int d0 = 0; d0 < 4; ++d0) { const int dd = 16 * d0 + 8 * hi; float qv[8]; unpack8(qp0[d0], qv);
                    const f32x4 b0 = *(const LAS f32x4*)(bL + (ti + rb) * HG_BP + dd), b1 = *(const LAS f32x4*)(bL + (ti + rb) * HG_BP + dd + 4);
                    const f32x4 m3 = {-3.f, -3.f, -3.f, -3.f}; const f32x4 c0 = b0 + m3, c1 = b1 + m3;
                    const bf16x8_t qa = __builtin_bit_cast(bf16x8_t, (v4u){pk_bf2((f32x2){qv[0], qv[1]} * ex2(c0.lo)), pk_bf2((f32x2){qv[2], qv[3]} * ex2(c0.hi)), pk_bf2((f32x2){qv[4], qv[5]} * ex2(c1.lo)), pk_bf2((f32x2){qv[6], qv[7]} * ex2(c1.hi))});
#pragma unroll
                    for (int eh = 0; eh < 2; ++eh) { const bf16x8_t sb = sfr[d0][eh];
                        if (eh) o01 = __builtin_amdgcn_mfma_f32_32x32x16_bf16(qa, sb, o01, 0, 0, 0); else o00 = __builtin_amdgcn_mfma_f32_32x32x16_bf16(qa, sb, o00, 0, 0, 0); }
                    __builtin_amdgcn_sched_barrier(0); }
#pragma unroll 1
                for (int J = dir ? I : 0; J <= (dir ? 1 : I); ++J) {
                    const int refrow = (I == J) ? (32 * I + 16) : 32;
                    const int tj = 32 * J + r32;
                    f32x16_t x = {};
#pragma unroll
                    for (int d0 = 0; d0 < 4; ++d0) { const int dd = 16 * d0 + 8 * hi;
                        const f32x4 r0 = *(const LAS f32x4*)(bL + refrow * HG_BP + dd), r1 = *(const LAS f32x4*)(bL + refrow * HG_BP + dd + 4);
                        const f32x4 bj0 = *(const LAS f32x4*)(bL + (tj + rb) * HG_BP + dd), bj1 = *(const LAS f32x4*)(bL + (tj + rb) * HG_BP + dd + 4);
                        const f32x4 bp0 = *(const LAS f32x4*)(bL + (tj + rp) * HG_BP + dd), bp1 = *(const LAS f32x4*)(bL + (tj + rp) * HG_BP + dd + 4);
                        const bf16x8_t ka = __builtin_bit_cast(bf16x8_t, (v4u){kt2(bj0.lo, bp0.lo, r0.lo), kt2(bj0.hi, bp0.hi, r0.hi), kt2(bj1.lo, bp1.lo, r1.lo), kt2(bj1.hi, bp1.hi, r1.hi)});
                        const f32x4 bi0 = *(const LAS f32x4*)(bL + (ti + rb) * HG_BP + dd), bi1 = *(const LAS f32x4*)(bL + (ti + rb) * HG_BP + dd + 4);
                        const f32x4 p3 = {3.f, 3.f, 3.f, 3.f}; const f32x4 r30 = r0 + p3, r31 = r1 + p3;
                        const v4u qw = qp0[d0];
                        const bf16x8_t qb = __builtin_bit_cast(bf16x8_t, (v4u){qt2(qw.x, bi0.lo, r30.lo), qt2(qw.y, bi0.hi, r30.hi), qt2(qw.z, bi1.lo, r31.lo), qt2(qw.w, bi1.hi, r31.hi)});
                        x = __builtin_amdgcn_mfma_f32_32x32x16_bf16(ka, qb, x, 0, 0, 0); __builtin_amdgcn_sched_barrier(0); }
                    if (I == J) {
#pragma unroll
                        for (int r = 0; r < 16; ++r) { const int jr = crow(r, hi); x[r] = (dir ? (jr >= r32) : (jr <= r32)) ? x[r] : 0.f; } }
                    const v4u pw0 = (v4u){pk_bf(x[0], x[1]), pk_bf(x[2], x[3]), pk_bf(x[4], x[5]), pk_bf(x[6], x[7])}, pw1 = (v4u){pk_bf(x[8], x[9]), pk_bf(x[10], x[11]), pk_bf(x[12], x[13]), pk_bf(x[14], x[15])};
#pragma unroll
                    for (int ks = 0; ks < 2; ++ks) { const bf16x8_t pa = __builtin_bit_cast(bf16x8_t, ks ? pw1 : pw0);
#pragma unroll
                        for (int eh = 0; eh < 2; ++eh) { const s16x4_t a0 = vtr16(vp + eh * 4096 + (2 * J + ks) * 1024), a1 = vtr16(vp + eh * 4096 + (2 * J + ks) * 1024 + 512);
                            const bf16x8_t vb = (bf16x8_t){a0[0], a0[1], a0[2], a0[3], a1[0], a1[1], a1[2], a1[3]};
                            if (eh) o01 = __builtin_amdgcn_mfma_f32_32x32x16_bf16(pa, vb, o01, 0, 0, 0); else o00 = __builtin_amdgcn_mfma_f32_32x32x16_bf16(pa, vb, o00, 0, 0, 0); } }
                }
                { const f32x16_t t0 = o00, t1 = o01; o00 = o10; o01 = o11; o10 = t0; o11 = t1; }
#pragma unroll
                for (int d0 = 0; d0 < 4; ++d0) { const v4u tq = qp0[d0]; qp0[d0] = qp1[d0]; qp1[d0] = tq; }
            }
            LDS_WAIT(); asm volatile("" ::: "memory");
        }
        const float og0 = p->in[10][layer * 64 + r32], og1 = p->in[10][layer * 64 + 32 + r32];
#pragma unroll 1
        for (int I = 0; I < 2; ++I) {
            const f32x16_t oa = I ? o10 : o00, ob = I ? o11 : o01;
            unsigned short gv0[16], gv1[16];
#pragma unroll
            for (int r = 0; r < 16; ++r) { const int row = row0 + 32 * I + crow(r, hi);
                const bf16* gp = (const bf16*)((const char*)P + (unsigned)(row * NP + HG_G + h * 64 + r32) * 2u); gv0[r] = gp[0]; gv1[r] = gp[32]; }
            asm volatile("" ::: "memory");
#pragma unroll
            for (int r = 0; r < 16; ++r) { const int row = row0 + 32 * I + crow(r, hi); const float t0 = oa[r], t1 = ob[r];
                float ss = t0 * t0 + t1 * t1; ss += DPP_F(ss, 0xB1); ss += DPP_F(ss, 0x4E); ss += DPP_F(ss, 0x141); ss += DPP_F(ss, 0x140);
                const float sa = rdlane(ss, 0) + rdlane(ss, 16), sb = rdlane(ss, 32) + rdlane(ss, 48);
                const float rs = __builtin_amdgcn_rsqf((hi ? sb : sa) * (1.f / 64.f) + EPS);
                const float g0 = bf2f(gv0[r]), g1 = bf2f(gv1[r]);
                bf16* mp = (bf16*)((char*)MIX + (unsigned)(row * 1024 + h * 64 + r32) * 2u);
                const unsigned pr2 = cvtpk(t0 * rs * og0 * g0 * sigm_fast(g0), t1 * rs * og1 * g1 * sigm_fast(g1));
                mp[0] = (bf16)(pr2 & 0xffffu); mp[32] = (bf16)(pr2 >> 16); }
        }
    }
}
__device__ __forceinline__ float row16_max_n(float v) { v = fmaxf(v, DPP_F(v, 0xB1)); v = fmaxf(v, DPP_F(v, 0x4E)); v = fmaxf(v, DPP_F(v, 0x141)); v = fmaxf(v, DPP_F(v, 0x140)); return v; }
__device__ __forceinline__ void ph_norm2_router_mfma(KA p, const Ctx& c, int layer, bool with_ctx) {
    const float* gain = p->in[7] + layer * 1024; const float* rw = p->in[17] + (size_t)layer * 1024 * 16;
    const bf16* X = (const bf16*)(c.ws + WS_X); bf16* H = (bf16*)(c.ws + WS_H); float* AFF = (float*)(c.ws + WS_AFF); int* SEL = (int*)(c.ws + WS_SEL);
    LAS v4u* RWH = (LAS v4u*)c.lds;
    LAS v4u* RWL = (LAS v4u*)(c.lds + 32768);
    LAS float* GS = (LAS float*)(c.lds + 65536);
    LAS float* SH = GS + 1024;
    LAS float* BIAS = SH + 1024;
    LAS float* PART = BIAS + 16;
    LAS float* RS = PART + 512 + c.wave * 16;
    int blk = blockIdx.x; asm volatile("" : "+s"(blk));
    const int tid = c.tid, lane = c.lane, r = lane & 15, q = lane >> 4;
    const int npass = c.G == 256 ? 1 : (with_ctx ? 9 : 8);
#pragma unroll 1
    for (int pass = 0; pass < npass; ++pass) {
    int bi, g0, ng, gs_ = 1;
    if (c.G == 256) {
        if (with_ctx) { if (blk < 240) { bi = blk / 30; const int jb = blk - bi * 30; ng = jb < 16 ? 9 : 8; g0 = bi * 256 + (jb < 16 ? 9 * jb : 144 + 8 * (jb - 16)); } else { bi = 8; ng = 8; g0 = 2048 + (blk - 240) * 8; } }
        else { bi = blk >> 5; ng = 8; g0 = blk * 8; } }
    else { bi = pass; const int n = bi < 8 ? 256 : 128; g0 = bi * 256 + blk; gs_ = c.G; ng = blk < n ? (n - blk + c.G - 1) / c.G : 0; }
    const float* mp = (const float*)(c.ws + WS_MOD) + ((size_t)layer * 9 + bi) * 6144;
    float rwv[4][8], rwb[32];
#pragma unroll
    for (int it = 0; it < 4; ++it) { const int wd = tid + 512 * it, k0 = (wd >> 4) * 8, e = wd & 15;
#pragma unroll
        for (int j = 0; j < 8; ++j) rwv[it][j] = rw[(k0 + j) * 16 + e]; }
#pragma unroll
    for (int kk = 0; kk < 32; ++kk) rwb[kk] = rw[(32 * (tid >> 4) + kk) * 16 + (tid & 15)];
    for (int i = tid; i < 1024; i += 512) { GS[i] = gain[i] * (1.f + mp[4096 + i]); SH[i] = mp[3072 + i]; }
    __syncthreads();
#pragma unroll
    for (int it = 0; it < 4; ++it) { const int wd = tid + 512 * it, k0 = (wd >> 4) * 8; unsigned hp[4], lp[4];
#pragma unroll
        for (int j = 0; j < 8; j += 2) { const float w0 = GS[k0 + j] * rwv[it][j], w1 = GS[k0 + j + 1] * rwv[it][j + 1];
            hp[j >> 1] = cvtpk(w0, w1); lp[j >> 1] = cvtpk(w0 - bf2f(hp[j >> 1] & 0xffffu), w1 - bf2f(hp[j >> 1] >> 16)); }
        RWH[wd] = (v4u){hp[0], hp[1], hp[2], hp[3]};
        RWL[wd] = (v4u){lp[0], lp[1], lp[2], lp[3]}; }
    { const int e = tid & 15, part = tid >> 4; float a = 0.f;
#pragma unroll
      for (int kk = 0; kk < 32; ++kk) a += SH[32 * part + kk] * rwb[kk];
      PART[part * 16 + e] = a; }
    __syncthreads();
    if (tid < 16) { float a = 0.f;
#pragma unroll
        for (int pt = 0; pt < 32; ++pt) a += PART[pt * 16 + tid];
        BIAS[tid] = a; }
    __syncthreads();
#pragma unroll 1
    for (int gi = c.wave; gi < ng; gi += 8) {
        asm volatile("" ::: "memory");
        const int row0 = (g0 + gi * gs_) * 16;
        const bf16* xp = X + (size_t)(row0 + r) * 1024 + 8 * q;
        v4u xa[32];
#pragma unroll
        for (int s = 0; s < 32; ++s) xa[s] = *(const v4u*)(xp + 32 * s);
        pg8::f32x4 ah = {0.f, 0.f, 0.f, 0.f}, al = ah, as = ah;
#pragma unroll
        for (int s = 0; s < 32; ++s) { const pg8::bf16x8 a = __builtin_bit_cast(pg8::bf16x8, xa[s]);
            const pg8::bf16x8 bh = __builtin_bit_cast(pg8::bf16x8, RWH[s * 64 + lane]), bl = __builtin_bit_cast(pg8::bf16x8, RWL[s * 64 + lane]);
            ah = __builtin_amdgcn_mfma_f32_16x16x32_bf16(a, bh, ah, 0, 0, 0); al = __builtin_amdgcn_mfma_f32_16x16x32_bf16(a, bl, al, 0, 0, 0); as = __builtin_amdgcn_mfma_f32_16x16x32_bf16(a, a, as, 0, 0, 0);
            if ((s & 7) == 7) asm volatile("" ::: "memory"); }
        if ((r >> 2) == q) { const int i = r & 3; const float ssv = i == 0 ? as[0] : i == 1 ? as[1] : i == 2 ? as[2] : as[3]; RS[r] = rsqrtf(ssv * (1.f / 1024.f) + EPS); }
        LDS_WAIT(); asm volatile("" ::: "memory");
        const float rs_r = RS[r]; const pg8::f32x4 rs4 = *(const LAS pg8::f32x4*)(RS + 4 * q); const float bias = BIAS[r];
#pragma unroll
        for (int i = 0; i < 4; ++i) { const float lg = rs4[i] * (ah[i] + al[i]) + bias;
            const float mx = row16_max_n(lg), pe = expf(lg - mx), sm = row16_sum_n(pe);
            AFF[(size_t)(row0 + 4 * q + i) * 16 + r] = pe * (1.f / sm); SEL[(size_t)(row0 + 4 * q + i) * 16 + r] = -1; }
        bf16* hp = H + (size_t)(row0 + r) * 1024 + 8 * q;
#pragma unroll
        for (int s = 0; s < 32; ++s) { float xv[8]; unpack8(xa[s], xv);
            const pg8::f32x4 g0v = *(const LAS pg8::f32x4*)(GS + 32 * s + 8 * q), g1v = *(const LAS pg8::f32x4*)(GS + 32 * s + 8 * q + 4), s0v = *(const LAS pg8::f32x4*)(SH + 32 * s + 8 * q), s1v = *(const LAS pg8::f32x4*)(SH + 32 * s + 8 * q + 4);
            *(v4u*)(hp + 32 * s) = (v4u){cvtpk(xv[0] * rs_r * g0v.x + s0v.x, xv[1] * rs_r * g0v.y + s0v.y), cvtpk(xv[2] * rs_r * g0v.z + s0v.z, xv[3] * rs_r * g0v.w + s0v.w),
                                         cvtpk(xv[4] * rs_r * g1v.x + s1v.x, xv[5] * rs_r * g1v.y + s1v.y), cvtpk(xv[6] * rs_r * g1v.z + s1v.z, xv[7] * rs_r * g1v.w + s1v.w)};
            if ((s & 3) == 3) asm volatile("" ::: "memory"); }
        LDS_WAIT(); asm volatile("" ::: "memory");
    }
    __syncthreads();
    }
}

__device__ __forceinline__ void ph_mla_prep16(KA p, const Ctx& c, int layer) {
    if (c.wave < HG1_WAVES) return;
    const int pw = c.wave - HG1_WAVES, lane = c.lane, r = lane & 15, q = lane >> 4;
    const bf16* P = (const bf16*)(c.ws + WS_P); bf16* AM = (bf16*)(c.ws + WS_AM); bf16* KM = (bf16*)(c.ws + WS_KM); const float* RT = (const float*)(c.ws + WS_ROPE);
    const float* gq = p->in[11] + layer * 256 + 8 * q; const float* gkv = p->in[13] + layer * 128 + 8 * q;
    LAS float* RS = (LAS float*)(c.lds + HG1_WAVES * HG_WAVE_BYTES) + pw * 32;
    f32x4 gqa[8][2], gka[4][2];
#pragma unroll
    for (int s = 0; s < 8; ++s) { gqa[s][0] = *(const f32x4*)(gq + 32 * s); gqa[s][1] = *(const f32x4*)(gq + 32 * s + 4); }
#pragma unroll
    for (int s = 0; s < 4; ++s) { gka[s][0] = *(const f32x4*)(gkv + 32 * s); gka[s][1] = *(const f32x4*)(gkv + 32 * s + 4); }
    const int half = q >> 1, p0 = 4 * (q & 1);
#pragma unroll 1
    for (int g = (int)blockIdx.x * (8 - HG1_WAVES) + pw; g < MALL / 16; g += c.G * (8 - HG1_WAVES)) {
        asm volatile("" ::: "memory");
        const int row = 16 * g + r; const bf16* pr = P + (size_t)row * NP;
        v4u xa[8], xk[4];
#pragma unroll
        for (int s = 0; s < 8; ++s) xa[s] = *(const v4u*)(pr + ML_CQ + 32 * s + 8 * q);
#pragma unroll
        for (int s = 0; s < 4; ++s) xk[s] = *(const v4u*)(pr + ML_CKV + 32 * s + 8 * q);
        const v2u x1w = *(const v2u*)(pr + ML_KR + 16 * half + p0), x2w = *(const v2u*)(pr + ML_KR + 16 * half + 8 + p0);
        const int tk = row & 4095, pos = half ? (tk & 63) : (tk >> 6);
        const f32x4 cs01 = *(const f32x4*)(RT + (pos * 8 + p0) * 2), cs23 = *(const f32x4*)(RT + (pos * 8 + p0) * 2 + 4);
        pg8::f32x4 aq = {0.f, 0.f, 0.f, 0.f}, ak = aq;
#pragma unroll
        for (int s = 0; s < 8; ++s) { const pg8::bf16x8 a = __builtin_bit_cast(pg8::bf16x8, xa[s]); aq = __builtin_amdgcn_mfma_f32_16x16x32_bf16(a, a, aq, 0, 0, 0); }
#pragma unroll
        for (int s = 0; s < 4; ++s) { const pg8::bf16x8 a = __builtin_bit_cast(pg8::bf16x8, xk[s]); ak = __builtin_amdgcn_mfma_f32_16x16x32_bf16(a, a, ak, 0, 0, 0); }
        if ((r >> 2) == q) { const int i = r & 3; const float sq = i == 0 ? aq[0] : i == 1 ? aq[1] : i == 2 ? aq[2] : aq[3], sk = i == 0 ? ak[0] : i == 1 ? ak[1] : i == 2 ? ak[2] : ak[3];
            RS[r] = rsqrtf(sq * (1.f / 256.f) + EPS); RS[16 + r] = rsqrtf(sk * (1.f / 128.f) + EPS); }
        LDS_WAIT(); asm volatile("" ::: "memory");
        const float rq = RS[r], rk = RS[16 + r];
        bf16* am = AM + (size_t)row * 384 + 8 * q;
#pragma unroll
        for (int s = 0; s < 8; ++s) { float xv[8]; unpack8(xa[s], xv);
            *(v4u*)(am + 32 * s) = (v4u){cvtpk(xv[0] * rq * gqa[s][0].x, xv[1] * rq * gqa[s][0].y), cvtpk(xv[2] * rq * gqa[s][0].z, xv[3] * rq * gqa[s][0].w),
                                         cvtpk(xv[4] * rq * gqa[s][1].x, xv[5] * rq * gqa[s][1].y), cvtpk(xv[6] * rq * gqa[s][1].z, xv[7] * rq * gqa[s][1].w)}; }
#pragma unroll
        for (int s = 0; s < 4; ++s) { float xv[8]; unpack8(xk[s], xv);
            *(v4u*)(am + 256 + 32 * s) = (v4u){cvtpk(xv[0] * rk * gka[s][0].x, xv[1] * rk * gka[s][0].y), cvtpk(xv[2] * rk * gka[s][0].z, xv[3] * rk * gka[s][0].w),
                                               cvtpk(xv[4] * rk * gka[s][1].x, xv[5] * rk * gka[s][1].y), cvtpk(xv[6] * rk * gka[s][1].z, xv[7] * rk * gka[s][1].w)}; }
        const float a0 = bf2f(x1w.x & 0xffffu), a1 = bf2f(x1w.x >> 16), a2 = bf2f(x1w.y & 0xffffu), a3 = bf2f(x1w.y >> 16);
        const float b0 = bf2f(x2w.x & 0xffffu), b1 = bf2f(x2w.x >> 16), b2 = bf2f(x2w.y & 0xffffu), b3 = bf2f(x2w.y >> 16);
        v4u kw; int b, kvi;
        if (row < MLAT) { b = row >> 12; kvi = row & 4095;
            kw = (v4u){cvtpk(a0 * cs01.x - b0 * cs01.y, a1 * cs01.z - b1 * cs01.w), cvtpk(a2 * cs23.x - b2 * cs23.y, a3 * cs23.z - b3 * cs23.w),
                       cvtpk(b0 * cs01.x + a0 * cs01.y, b1 * cs01.z + a1 * cs01.w), cvtpk(b2 * cs23.x + a2 * cs23.y, b3 * cs23.z + a3 * cs23.w)}; }
        else { const int rr = row - MLAT; b = rr >> 8; kvi = T + (rr & 255); kw = (v4u){x1w.x, x1w.y, x2w.x, x2w.y}; }
        const int tile = kvi >> 6, kvr = kvi & 63;
#pragma unroll
        for (int h = 0; h < 6; ++h) *(v4u*)(KM + ((size_t)((b * 6 + h) * NKT + tile) * 12 + 8 + q) * 512 + kvr * 8) = kw;
        LDS_WAIT(); asm volatile("" ::: "memory");
    }
}
typedef pg8::f32x4 A4;
struct EpiP {
    static constexpr bool PERM = true, AFTER_DRAIN = false;
    bf16* O; int ldc;
    __device__ __forceinline__ void operator()(const A4 (&acc)[2][2][4][2], const pg8::Unit& u, int wr, int wc, int fr, int fq) const {
        const int row0 = u.pm * 256 + wr * 64 + fr, col0 = u.pn * 256 + wc * 32 + 8 * fq;
#pragma unroll
        for (int ai = 0; ai < 2; ++ai)
#pragma unroll
            for (int m = 0; m < 4; ++m) { bf16* rp = O + (size_t)(row0 + ai * 128 + m * 16) * ldc + col0;
#pragma unroll
                for (int bj = 0; bj < 2; ++bj) { const A4 v0 = acc[ai][bj][m][0], v1 = acc[ai][bj][m][1];
                    *(v4u*)(rp + bj * 128) = (v4u){pg8::cvt_pk_bf16(v0[0], v0[1]), pg8::cvt_pk_bf16(v0[2], v0[3]), pg8::cvt_pk_bf16(v1[0], v1[1]), pg8::cvt_pk_bf16(v1[2], v1[3])}; } }
    }
};
struct EpiMla {
    static constexpr bool PERM = true, AFTER_DRAIN = false;
    unsigned char* ws;
    __device__ __forceinline__ void operator()(const A4 (&acc)[2][2][4][2], const pg8::Unit& u, int wr, int wc, int fr, int fq) const {
        const int part = u.pn >= 3 ? 1 : 0, hp = u.pn - part * 3;
        if (part == 0 && wc == 3) return;
        bf16* QM = (bf16*)(ws + WS_QM); bf16* KM = (bf16*)(ws + WS_KM); bf16* VM = (bf16*)(ws + WS_VM); const float* RT = (const float*)(ws + WS_ROPE);
#pragma unroll
        for (int ai = 0; ai < 2; ++ai) {
            A4 rc[4][2];
            if (part == 0 && wc == 2) {
#pragma unroll
                for (int m = 0; m < 4; ++m) { const int row = u.pm * 256 + ai * 128 + wr * 64 + m * 16 + fr, t = row & 4095, half = fq >> 1, pos = half ? (t & 63) : (t >> 6);
                    const float* rt = RT + (pos * 8 + 4 * (fq & 1)) * 2; rc[m][0] = *(const A4*)rt; rc[m][1] = *(const A4*)(rt + 4); } }
#pragma unroll
            for (int m = 0; m < 4; ++m) {
                asm volatile("" ::: "memory");
                const int row = u.pm * 256 + ai * 128 + wr * 64 + m * 16 + fr;
                int b, qi, t; bool isctx;
                if (row < MLAT) { b = row >> 12; t = row & 4095; qi = t; isctx = false; } else { const int rr = row - MLAT; b = rr >> 8; t = 0; qi = T + (rr & 255); isctx = true; }
                const int tile = qi >> 6, kvr = qi & 63;
#pragma unroll
                for (int bj = 0; bj < 2; ++bj) { const int bh = b * 6 + 2 * hp + bj; A4 v0 = acc[ai][bj][m][0], v1 = acc[ai][bj][m][1];
                    if (part == 0) {
                        if (wc == 2 && !isctx) {
                            const A4 c01 = rc[m][0], c23 = rc[m][1];
                            const A4 x1 = v0, x2 = v1;
                            v0 = (A4){x1[0] * c01[0] - x2[0] * c01[1], x1[1] * c01[2] - x2[1] * c01[3], x1[2] * c23[0] - x2[2] * c23[1], x1[3] * c23[2] - x2[3] * c23[3]};
                            v1 = (A4){x2[0] * c01[0] + x1[0] * c01[1], x2[1] * c01[2] + x1[1] * c01[3], x2[2] * c23[0] + x1[2] * c23[1], x2[3] * c23[2] + x1[3] * c23[3]}; }
                        v0 = v0 * MLA_QS; v1 = v1 * MLA_QS;
                        *(v4u*)(QM + ((size_t)bh * NQK + qi) * 96 + wc * 32 + 8 * fq) = (v4u){pg8::cvt_pk_bf16(v0[0], v0[1]), pg8::cvt_pk_bf16(v0[2], v0[3]), pg8::cvt_pk_bf16(v1[0], v1[1]), pg8::cvt_pk_bf16(v1[2], v1[3])};
                    } else {
                        const v4u w = (v4u){pg8::cvt_pk_bf16(v0[0], v0[1]), pg8::cvt_pk_bf16(v0[2], v0[3]), pg8::cvt_pk_bf16(v1[0], v1[1]), pg8::cvt_pk_bf16(v1[2], v1[3])};
                        if (wc < 2) *(v4u*)(KM + ((size_t)(bh * NKT + tile) * 12 + 4 * wc + fq) * 512 + kvr * 8) = w;
                        else *(v4u*)(VM + ((size_t)(bh * NKT + tile) * 2 + (wc - 2)) * 2048 + kvr * 32 + fq * 8) = w;
                    } }
            }
        }
    }
};
struct EpiOut {
    static constexpr bool PERM = true, AFTER_DRAIN = false;
    bf16* X; const float* xlat; const float* xctx; const float* MODl; float scale; int src_f32;
    __device__ __forceinline__ void operator()(const A4 (&acc)[2][2][4][2], const pg8::Unit& u, int wr, int wc, int fr, int fq) const {
        const int row0 = u.pm * 256 + wr * 64 + fr, col0 = u.pn * 256 + wc * 32 + 8 * fq;
        const int bi = (u.pm < MLAT / 256) ? (u.pm >> 4) : 8; const float* ga = MODl + bi * 6144 + 2048;
        A4 gav[2][2];
#pragma unroll
        for (int bj = 0; bj < 2; ++bj) { gav[bj][0] = *(const A4*)(ga + col0 + bj * 128) * scale; gav[bj][1] = *(const A4*)(ga + col0 + bj * 128 + 4) * scale; }
        if (!src_f32) {
#pragma unroll
            for (int ai = 0; ai < 2; ++ai) {
                v4u wb[4][2];
#pragma unroll
                for (int m = 0; m < 4; ++m) { const bf16* dstc = X + (size_t)(row0 + ai * 128 + m * 16) * 1024;
#pragma unroll
                    for (int bj = 0; bj < 2; ++bj) wb[m][bj] = *(const v4u*)(dstc + col0 + bj * 128); }
                asm volatile("" ::: "memory");
#pragma unroll
                for (int m = 0; m < 4; ++m) { bf16* dst = X + (size_t)(row0 + ai * 128 + m * 16) * 1024;
#pragma unroll
                    for (int bj = 0; bj < 2; ++bj) { const int col = col0 + bj * 128; const v4u w = wb[m][bj];
                        const A4 x0 = (A4){bf2f(w.x & 0xffffu), bf2f(w.x >> 16), bf2f(w.y & 0xffffu), bf2f(w.y >> 16)}, x1 = (A4){bf2f(w.z & 0xffffu), bf2f(w.z >> 16), bf2f(w.w & 0xffffu), bf2f(w.w >> 16)};
                        const A4 v0 = x0 + gav[bj][0] * acc[ai][bj][m][0], v1 = x1 + gav[bj][1] * acc[ai][bj][m][1];
                        *(v4u*)(dst + col) = (v4u){pg8::cvt_pk_bf16(v0[0], v0[1]), pg8::cvt_pk_bf16(v0[2], v0[3]), pg8::cvt_pk_bf16(v1[0], v1[1]), pg8::cvt_pk_bf16(v1[2], v1[3])}; } }
                asm volatile("" ::: "memory"); }
        } else {
#pragma unroll
            for (int aim = 0; aim < 4; ++aim) { const int ai = aim >> 1, m0 = (aim & 1) * 2;
                A4 xf[4][2][2];
#pragma unroll
                for (int m = m0; m < m0 + 2; ++m) { const int row = row0 + ai * 128 + m * 16;
                    const float* src = row < MLAT ? xlat + (size_t)row * 1024 : xctx + (size_t)(row - MLAT) * 1024;
#pragma unroll
                    for (int bj = 0; bj < 2; ++bj) { const int col = col0 + bj * 128; xf[m][bj][0] = *(const A4*)(src + col); xf[m][bj][1] = *(const A4*)(src + col + 4); } }
                asm volatile("" ::: "memory");
#pragma unroll
                for (int m = m0; m < m0 + 2; ++m) { bf16* dst = X + (size_t)(row0 + ai * 128 + m * 16) * 1024;
#pragma unroll
                    for (int bj = 0; bj < 2; ++bj) { const int col = col0 + bj * 128;
                        const A4 v0 = xf[m][bj][0] + gav[bj][0] * acc[ai][bj][m][0], v1 = xf[m][bj][1] + gav[bj][1] * acc[ai][bj][m][1];
                        *(v4u*)(dst + col) = (v4u){pg8::cvt_pk_bf16(v0[0], v0[1]), pg8::cvt_pk_bf16(v0[2], v0[3]), pg8::cvt_pk_bf16(v1[0], v1[1]), pg8::cvt_pk_bf16(v1[2], v1[3])}; } }
                asm volatile("" ::: "memory"); }
        }
    }
};
struct EpiAct {
    static constexpr bool PERM = true, AFTER_DRAIN = false;
    bf16* ACT;
    __device__ __forceinline__ void operator()(const A4 (&acc)[2][2][4][2], const pg8::Unit& u, int wr, int wc, int fr, int fq) const {
        const int row0 = u.pm * 256 + wr * 64 + fr, col0 = (u.pn & 7) * 128 + wc * 32 + 8 * fq;
#pragma unroll
        for (int ai = 0; ai < 2; ++ai)
#pragma unroll
            for (int m = 0; m < 4; ++m) { float r[8];
#pragma unroll
                for (int n = 0; n < 2; ++n)
#pragma unroll
                    for (int i = 0; i < 4; ++i) { const float a = acc[ai][0][m][n][i], g = acc[ai][1][m][n][i]; r[n * 4 + i] = a * g * __builtin_amdgcn_rcpf(1.f + __builtin_amdgcn_exp2f(-a * LOG2E)); }
                *(v4u*)(ACT + (size_t)(row0 + ai * 128 + m * 16) * 1024 + col0) = (v4u){pg8::cvt_pk_bf16(r[0], r[1]), pg8::cvt_pk_bf16(r[2], r[3]), pg8::cvt_pk_bf16(r[4], r[5]), pg8::cvt_pk_bf16(r[6], r[7])}; }
    }
};
struct EpiY {
    static constexpr bool PERM = true, AFTER_DRAIN = false;
    bf16* Y;
    __device__ __forceinline__ void operator()(const A4 (&acc)[2][2][4][2], const pg8::Unit& u, int wr, int wc, int fr, int fq) const {
        const int row0 = u.pm * 256 + wr * 64 + fr, col0 = (u.pn & 3) * 256 + wc * 32 + 8 * fq;
#pragma unroll
        for (int ai = 0; ai < 2; ++ai)
#pragma unroll
            for (int m = 0; m < 4; ++m) { bf16* rp = Y + (size_t)(row0 + ai * 128 + m * 16) * 1024 + col0;
#pragma unroll
                for (int bj = 0; bj < 2; ++bj) { const A4 v0 = acc[ai][bj][m][0], v1 = acc[ai][bj][m][1];
                    *(v4u*)(rp + bj * 128) = (v4u){pg8::cvt_pk_bf16(v0[0], v0[1]), pg8::cvt_pk_bf16(v0[2], v0[3]), pg8::cvt_pk_bf16(v1[0], v1[1]), pg8::cvt_pk_bf16(v1[2], v1[3])}; } }
    }
};
struct SchedE1 {
    int G, c, nunits;
    __device__ __forceinline__ bool next(int i, pg8::Unit& u) const { const int L = i * G + c; if (L >= nunits) return false; u.kt0 = 0; u.ntu = 0;
        if (L < 2048) { const int rnd = L >> 8, x = L & 7, j = (L >> 3) & 31, e = 2 * rnd + (x >> 2), mt = (x & 3) * 4 + (j & 3), pnl = j >> 2;
            u.pm = ((mt >> 1) * 16 + e) * 2 + (mt & 1); u.pn = e * 8 + pnl; }
        else { const int r = L - 2048, e = r >> 3; u.pm = 256 + e; u.pn = e * 8 + (r & 7); }
        return true; }
    __device__ __forceinline__ void a_ready(const pg8::Unit&) const {}
    __device__ __forceinline__ void done(const pg8::Unit&) const {}
};
struct SchedE2 {
    int G, c, nunits;
    __device__ __forceinline__ bool next(int i, pg8::Unit& u) const { const int L = i * G + c; if (L >= nunits) return false; u.kt0 = 0; u.ntu = 0;
        if (L < 1024) { const int rnd = L >> 8, x = L & 7, j = (L >> 3) & 31, e = 4 * rnd + (x >> 1), mt = (x & 1) * 8 + (j & 7), pnl = j >> 3;
            u.pm = ((mt >> 1) * 16 + e) * 2 + (mt & 1); u.pn = e * 4 + pnl; }
        else { const int r = L - 1024, e = r >> 2; u.pm = 256 + e; u.pn = e * 4 + (r & 3); }
        return true; }
    __device__ __forceinline__ void a_ready(const pg8::Unit&) const {}
    __device__ __forceinline__ void done(const pg8::Unit&) const {}
};
#ifndef MK_SIMPLE_ATTN
#define MK_SIMPLE_ATTN 0
#endif
#ifndef MK_HGRN_MFMA
#define MK_HGRN_MFMA 1
#endif
#ifndef MK_MLA_V2
#define MK_MLA_V2 1
#endif
#ifndef MK_REP
#define MK_REP 0
#endif
#define REP(id) for (int rep_ = 0; rep_ < ((MK_REP == (id)) ? 2 : 1); ++rep_)
#ifndef MK_PHMASK
#define MK_PHMASK 0xfff
#endif
#define PHEN(i) ((MK_PHMASK >> (i)) & 1)
constexpr int CW_BAR = 1024;

__global__ void __launch_bounds__(512, 2) mk_fwd(KP pv) {
    extern __shared__ __attribute__((aligned(16))) unsigned char lds_raw[];
    Ctx c; c.lds = (LAS unsigned char*)lds_raw; c.ws = pv.ws; c.wave = __builtin_amdgcn_readfirstlane((int)threadIdx.x >> 6); c.lane = lane_id_asm(); c.tid = c.wave * 64 + c.lane;
    c.G = gridDim.x; c.gw = blockIdx.x * 8 + c.wave; c.NGW = c.G * 8;
    volatile LAS unsigned* MISC = (volatile LAS unsigned*)(c.lds + MISC_OFF);
    if (c.tid < 64) MISC[c.tid] = 0u;
    __syncthreads();
    const int li_s = pv.li; (void)xcd_barrier_post((unsigned*)(pv.ws + WS_CTL) + CW_BAR + pv.li * XCD_BAR_WORDS, MISC + 8);
    const int ph_lo = pv.ph_lo, ph_hi = pv.ph_hi; KA p;
    int gp = 0;
#define RUN(k) (ph_lo <= (k) && (k) < ph_hi)
#ifndef MK_BARX
#define MK_BARX 1
#endif
#define SEAM(k) do { if (RUN(k) && RUN((k) + 1)) { for (int bx_ = 0; bx_ < MK_BARX; ++bx_) { const int l_ = lane_id_asm(); XcdBarrier b_; b_.bar = (unsigned*)(c0.ws + WS_CTL) + CW_BAR + li_s * XCD_BAR_WORDS; b_.x = xb_xcc_id(); b_.st = MISC + 8; xcd_barrier(b_, c0.wave == 0 && l_ == 0); } } } while (0)
    LAS unsigned char* ring = c.lds;
    const Ctx c0 = c;
#define FRESH() do { c = c0; p = (KA)__builtin_amdgcn_kernarg_segment_ptr(); c.lane = lane_id_asm(); asm volatile("" : "+s"(c.wave), "+s"(c.gw), "+s"(p)); c.tid = c.wave * 64 + c.lane; c.ws = p->ws; } while (0)

    if (PHEN(0) && RUN(gp)) { FRESH(); REP(16) { ph_prologue(p, c); __syncthreads(); } }
    SEAM(gp); ++gp;

#pragma unroll 1
    for (int layer = 0; layer < DEPTH; ++layer) {
        const bool with_ctx = layer < DEPTH - 1;
#define XLAT (p->in[0])
#define XCTX (p->in[2])
#define MODL ((const float*)(c.ws + WS_MOD) + (size_t)layer * 9 * 6144)
        if (PHEN(1) && RUN(gp)) { FRESH(); REP(1) { ph_convert(p, c, layer); }     if (MK_REP == 18 && layer > 0) ph_norm<false, true, true>(p, c, layer, XLAT, XCTX, MALL); REP(2) { if (layer == 0) ph_norm4<false, false>(p, c, layer, XLAT, XCTX, MALL); else ph_norm<false, true>(p, c, layer, XLAT, XCTX, MALL); } }
        SEAM(gp); ++gp;
        if (PHEN(2) && RUN(gp)) { FRESH(); pg8::Gemm g{(const bf16*)(c.ws + WS_H), (const bf16*)(c.ws + WS_WIN), MALL, NP, 1024}; pg8::StaticOrder S; S.init(MALL, NP, c.G, (int)blockIdx.x);
            EpiP E{(bf16*)(c.ws + WS_P), NP}; REP(10) pg8::gemm_phase<EpiP, pg8::StaticOrder, true, true, 1024>(ring, g, S, E, c.wave); }
        SEAM(gp); ++gp;
        if (PHEN(3) && RUN(gp)) { FRESH(); REP(3) { if (MK_HGRN_MFMA) ph_hgrn1_mfma(p, c, layer); else ph_hgrn_pass1(p, c, layer); } FRESH(); REP(4) ph_mla_prep16(p, c, layer); }
        SEAM(gp); ++gp;
        if (PHEN(4) && RUN(gp)) { FRESH(); if (MK_HGRN_MFMA) ph_hgrn_scan_t(c); else ph_hgrn_scan(c);
            pg8::Gemm g{(const bf16*)(c.ws + WS_AM), (const bf16*)(c.ws + WS_WMLA), MALL, 1536, 384}; pg8::StaticOrder S; S.init(MALL, 1536, c.G, (int)blockIdx.x); S.bdiag = 1;
            EpiMla E{c.ws};
            __syncthreads(); REP(11) pg8::gemm_phase<EpiMla, pg8::StaticOrder, true, true, 384>(ring, g, S, E, c.wave); }
        SEAM(gp); ++gp;
        if (PHEN(5) && RUN(gp)) { FRESH(); REP(5) { if (MK_HGRN_MFMA) ph_hgrn3_mfma(p, c, layer, with_ctx); else ph_hgrn_pass3(p, c, layer, with_ctx); } if (MK_SIMPLE_ATTN & 1) ph_attn_mla_simple(c, with_ctx); else REP(6) { __syncthreads(); FRESH(); if (MK_MLA_V2) ph_attn_mla2(c, with_ctx); else ph_attn_mla(c, with_ctx); } if (MK_SIMPLE_ATTN & 2) ph_attn_na_simple(p, c, layer, with_ctx); else REP(7) { __syncthreads(); FRESH(); ph_attn_na(p, c, layer, with_ctx); } }
        SEAM(gp); ++gp;
        if (PHEN(6) && RUN(gp)) { FRESH(); const int M = with_ctx ? MALL : MLAT; pg8::Gemm g{(const bf16*)(c.ws + WS_MIX), (const bf16*)(c.ws + WS_WOUT), M, 1024, 1024}; pg8::StaticOrder S; S.init(M, 1024, c.G, (int)blockIdx.x);
            REP(15) { EpiOut E{(bf16*)(c.ws + WS_X), XLAT, XCTX, MODL, rep_ ? 0.f : 1.f, (layer == 0 && !rep_) ? 1 : 0}; pg8::gemm_phase<EpiOut, pg8::StaticOrder, true, true, 1024>(ring, g, S, E, c.wave); } }
        SEAM(gp); ++gp;
        if (PHEN(7) && RUN(gp)) { FRESH(); REP(9) ph_norm2_router_mfma(p, c, layer, with_ctx); }
        SEAM(gp); ++gp;
        if (PHEN(8) && RUN(gp)) { FRESH(); REP(8) { __syncthreads(); ph_topk(c, with_ctx); } }
        SEAM(gp); ++gp;
        if (PHEN(9) && RUN(gp)) { FRESH(); pg8::Gemm g{(const bf16*)(c.ws + WS_H), (const bf16*)(c.ws + WS_W13), XS_ROWS, 2048 * NE, 1024};     SchedE1 S{c.G, (int)blockIdx.x, with_ctx ? 2176 : 2048};
            EpiAct E{(bf16*)(c.ws + WS_ACT)}; __syncthreads(); REP(13) pg8::gemm_phase<EpiAct, SchedE1, true, true, 1024, true>(ring, g, S, E, c.wave, (const int*)(c.ws + WS_IDX)); }
        SEAM(gp); ++gp;
        if (PHEN(10) && RUN(gp)) { FRESH(); pg8::Gemm g{(const bf16*)(c.ws + WS_ACT), (const bf16*)(c.ws + WS_W2), XS_ROWS, 1024 * NE, 1024}; SchedE2 S{c.G, (int)blockIdx.x, with_ctx ? 1088 : 1024};
            EpiY E{(bf16*)(c.ws + WS_Y)}; REP(14) pg8::gemm_phase<EpiY, SchedE2, true, true, 1024>(ring, g, S, E, c.wave); }
        SEAM(gp); ++gp;
    }
    if (PHEN(11) && RUN(gp)) { FRESH(); REP(17) ph_final(p, c); }
#undef RUN
#undef SEAM
}

#ifndef MK_N_LAUNCHES
#define MK_N_LAUNCHES 1
#endif
extern "C" void kernel_launch(void* const* d_in, const int* in_sizes, int n_in, void* d_out, int out_size, void* d_ws, size_t ws_size, hipStream_t stream) {
    static int grid = 0;
    if (grid == 0) {
        if (n_in != 22 || ws_size < WS_END) { fprintf(stderr, "kernel_launch: expected 22 inputs and >= %zu bytes of workspace; got %d, %zu\n", (size_t)WS_END, n_in, ws_size); grid = -1; return; }
        int dev = 0, cus = 0, per_cu = 0;
        if (hipGetDevice(&dev) != hipSuccess || hipDeviceGetAttribute(&cus, hipDeviceAttributeMultiprocessorCount, dev) != hipSuccess) { grid = -1; return; }
        if (hipFuncSetAttribute((const void*)mk_fwd, hipFuncAttributeMaxDynamicSharedMemorySize, LDS_BYTES) != hipSuccess) { fprintf(stderr, "kernel_launch: hipFuncSetAttribute failed\n"); grid = -1; return; }
        if (hipOccupancyMaxActiveBlocksPerMultiprocessor(&per_cu, (const void*)mk_fwd, 512, LDS_BYTES) != hipSuccess || per_cu < 1) { fprintf(stderr, "kernel_launch: occupancy query reports %d\n", per_cu); }
        (void)hipGetLastError();
        grid = cus;
        if (grid > 256) grid = 256;
    }
    if (grid < 0) return;
    (void)in_sizes; (void)out_size;
    if (hipMemsetAsync((char*)d_ws + WS_CTL, 0, CTL_BYTES, stream) != hipSuccess) return;
    KP a{};
    for (int i = 0; i < 22; ++i) a.in[i] = (const float*)d_in[i];
    a.out = (float*)d_out; a.ws = (unsigned char*)d_ws; a.pad = 0;
    if (MK_N_LAUNCHES == 1) { a.ph_lo = 0; a.ph_hi = NPHASES; a.li = 0; hipLaunchKernelGGL(mk_fwd, dim3(grid), dim3(512), LDS_BYTES, stream, a); }
    else { for (int k = 0; k < NPHASES; ++k) { a.ph_lo = k; a.ph_hi = k + 1; a.li = k; hipLaunchKernelGGL(mk_fwd, dim3(grid), dim3(512), LDS_BYTES, stream, a); } }
}
```
